# Optimizing an MI355X kernel written in HIP

```python
import math
import jax, jax.numpy as jnp
from jax import lax
import numpy as np

D_MODEL = 4096
BATCH = 2
SEQ = 8192
DEPTH = 1

CHUNK = 64
Q_BLOCK = 128
EPS = 1e-6
ROPE_THETA = 500000.0

DA_HEADS = 8
DA_QK_DIM = D_MODEL // 32
DA_V_DIM = 2 * DA_QK_DIM
DA_WIDTH = DA_HEADS * DA_V_DIM
DA_QK_WIDTH = DA_HEADS * 2 * DA_QK_DIM
ROPE_DIM = DA_QK_DIM // 4

POOL_WINDOWS = (2, 4, 8, 16)
POOL_GROUPS = len(POOL_WINDOWS)
POOL_WIDTH = D_MODEL // 4
POOL_GDIM = POOL_WIDTH // POOL_GROUPS

MEM_LEN = 256
MEM_HEADS = 4
MEM_HEAD_DIM = D_MODEL // 16
MEM_WIDTH = MEM_HEADS * MEM_HEAD_DIM

N_BRANCHES = 3
IN_WIDTH = 3 * DA_QK_WIDTH + POOL_WIDTH + MEM_WIDTH + N_BRANCHES * D_MODEL

D_FF = ((8 * D_MODEL // 3 + 255) // 256) * 256
CONV_W = 3

kernel_name = "hybrid_diffattn_pool_mem_convffn"


def rmsnorm(x, g):
    xf = x.astype(jnp.float32)
    y = xf * lax.rsqrt(jnp.mean(xf * xf, axis=-1, keepdims=True) + EPS)
    return y.astype(x.dtype) * g


def rope_tables(seq):
    pos = jnp.arange(seq, dtype=jnp.float32)
    inv = ROPE_THETA ** (-jnp.arange(0, ROPE_DIM, 2, dtype=jnp.float32) / ROPE_DIM)
    ang = pos[:, None] * inv[None, :]
    return jnp.cos(ang), jnp.sin(ang)


def partial_rope(x, cos, sin):
    half = ROPE_DIM // 2
    c = cos[:, None, None, :].astype(x.dtype)
    s = sin[:, None, None, :].astype(x.dtype)
    x1 = x[..., :half]
    x2 = x[..., half:ROPE_DIM]
    rot = jnp.concatenate([x1 * c - x2 * s, x2 * c + x1 * s], axis=-1)
    return jnp.concatenate([rot, x[..., ROPE_DIM:]], axis=-1)


def diff_attention(q, k, v, lam, g_subln, lambda_init):
    b, s = q.shape[0], q.shape[1]
    nblk = s // Q_BLOCK
    scale = DA_QK_DIM ** -0.5
    key_chunk = jnp.arange(s) // CHUNK
    qb = q.reshape(b, nblk, Q_BLOCK, DA_HEADS, 2, DA_QK_DIM).transpose(1, 0, 2, 3, 4, 5)
    neg = jnp.finfo(jnp.float32).min

    def block(args):
        qblk, i = args
        q_chunk = (i * Q_BLOCK + jnp.arange(Q_BLOCK)) // CHUNK
        allowed = key_chunk[None, :] <= q_chunk[:, None]
        sc = jnp.einsum('bqhcd,bkhcd->bhcqk', qblk, k).astype(jnp.float32) * scale
        sc = jnp.where(allowed, sc, neg)
        p = jax.nn.softmax(sc, axis=-1)
        a = p[:, :, 0] - lam * p[:, :, 1]
        return jnp.einsum('bhqk,bkhd->bqhd', a.astype(v.dtype), v)

    o = lax.map(block, (qb, jnp.arange(nblk)))
    o = o.transpose(1, 0, 2, 3, 4).reshape(b, s, DA_HEADS, DA_V_DIM)
    o = rmsnorm(o, g_subln) * (1.0 - lambda_init)
    return o.reshape(b, s, DA_WIDTH)


def pool_mixer(u, w_pool, pool_scale):
    b, s = u.shape[0], u.shape[1]
    ug = u.reshape(b, s, POOL_GROUPS, POOL_GDIM)
    cs = jnp.cumsum(ug.astype(jnp.float32), axis=1)
    cs_pad = jnp.pad(cs, ((0, 0), (1, 0), (0, 0), (0, 0)))
    win = jnp.array(POOL_WINDOWS, dtype=jnp.int32)
    t = jnp.arange(s, dtype=jnp.int32)[:, None]
    lo = jnp.maximum(t + 1 - win[None, :], 0)
    gidx = jnp.arange(POOL_GROUPS)[None, :]
    lower = cs_pad[:, lo, gidx, :]
    cnt = jnp.minimum(t + 1, win[None, :]).astype(jnp.float32)
    mean = (cs_pad[:, 1:] - lower) / cnt[None, :, :, None]
    y = (mean - ug.astype(jnp.float32)).astype(u.dtype)
    y = jnp.einsum('bsgi,gio->bsgo', y, w_pool) * pool_scale
    return y.reshape(b, s, POOL_WIDTH)


def mem_attention(qm, mem, g_mem, w_mkv, g_qm, g_km):
    b, s = qm.shape[0], qm.shape[1]
    q = rmsnorm(qm.reshape(b, s, MEM_HEADS, MEM_HEAD_DIM), g_qm)
    kv = (rmsnorm(mem, g_mem) @ w_mkv).reshape(b, mem.shape[1], 2, MEM_HEADS, MEM_HEAD_DIM)
    k = rmsnorm(kv[:, :, 0], g_km)
    v = kv[:, :, 1]
    sc = jnp.einsum('bshd,bmhd->bhsm', q, k).astype(jnp.float32) * (MEM_HEAD_DIM ** -0.5)
    p = jax.nn.softmax(sc, axis=-1).astype(v.dtype)
    o = jnp.einsum('bhsm,bmhd->bshd', p, v)
    return o.reshape(b, s, MEM_WIDTH)


def conv_ffn(h, w_up, conv_w, conv_b, w_down):
    u = h @ w_up
    up = jnp.pad(u, ((0, 0), (CONV_W - 1, 0), (0, 0)))
    s = u.shape[1]
    u = up[:, 0:s] * conv_w[0] + up[:, 1:s + 1] * conv_w[1] + up[:, 2:s + 2] * conv_w[2] + conv_b
    gate, val = jnp.split(u, 2, axis=-1)
    return (jax.nn.silu(gate) * val) @ w_down


def setup_inputs(seed: int = 0) -> dict:
    key = jax.random.key(seed)
    ks = jax.random.split(key, 32)
    f32 = jnp.float32
    nrm = lambda k, shape, scale: jax.random.normal(k, shape, f32) * scale
    gain = lambda k, shape: 1.0 + 0.1 * jax.random.normal(k, shape, f32)
    L = DEPTH
    return {
        "x": nrm(ks[0], (BATCH, SEQ, D_MODEL), 1.0),
        "mem": nrm(ks[1], (BATCH, MEM_LEN, D_MODEL), 1.0),
        "g_attn_norm": gain(ks[2], (L, D_MODEL)),
        "w_in": nrm(ks[3], (L, D_MODEL, IN_WIDTH), D_MODEL ** -0.5),
        "g_qa": gain(ks[4], (L, DA_QK_DIM)),
        "g_ka": gain(ks[5], (L, DA_QK_DIM)),
        "lam_q1": nrm(ks[6], (L, DA_QK_DIM), 0.1),
        "lam_k1": nrm(ks[7], (L, DA_QK_DIM), 0.1),
        "lam_q2": nrm(ks[8], (L, DA_QK_DIM), 0.1),
        "lam_k2": nrm(ks[9], (L, DA_QK_DIM), 0.1),
        "g_subln": gain(ks[10], (L, DA_V_DIM)),
        "w_pool": nrm(ks[11], (L, POOL_GROUPS, POOL_GDIM, POOL_GDIM), POOL_GDIM ** -0.5),
        "pool_scale": gain(ks[12], (L, POOL_GROUPS, POOL_GDIM)),
        "g_mem": gain(ks[13], (L, D_MODEL)),
        "w_mkv": nrm(ks[14], (L, D_MODEL, 2 * MEM_WIDTH), D_MODEL ** -0.5),
        "g_qm": gain(ks[15], (L, MEM_HEAD_DIM)),
        "g_km": gain(ks[16], (L, MEM_HEAD_DIM)),
        "w_a": nrm(ks[17], (L, DA_WIDTH, D_MODEL), DA_WIDTH ** -0.5),
        "w_b": nrm(ks[18], (L, POOL_WIDTH, D_MODEL), POOL_WIDTH ** -0.5),
        "w_c": nrm(ks[19], (L, MEM_WIDTH, D_MODEL), MEM_WIDTH ** -0.5),
        "w_o": nrm(ks[20], (L, D_MODEL, D_MODEL), D_MODEL ** -0.5),
        "g_ffn_norm": gain(ks[21], (L, D_MODEL)),
        "w_up": nrm(ks[22], (L, D_MODEL, 2 * D_FF), D_MODEL ** -0.5),
        "conv_w": nrm(ks[23], (L, CONV_W, 2 * D_FF), CONV_W ** -0.5),
        "conv_b": nrm(ks[24], (L, 2 * D_FF), 0.01),
        "w_down": nrm(ks[25], (L, D_FF, D_MODEL), D_FF ** -0.5),
    }


def reference(x, mem, g_attn_norm, w_in, g_qa, g_ka, lam_q1, lam_k1, lam_q2, lam_k2,
              g_subln, w_pool, pool_scale, g_mem, w_mkv, g_qm, g_km, w_a, w_b, w_c,
              w_o, g_ffn_norm, w_up, conv_w, conv_b, w_down):
    b, s = x.shape[0], x.shape[1]
    cos, sin = rope_tables(s)
    splits = np.cumsum([DA_QK_WIDTH, DA_QK_WIDTH, DA_QK_WIDTH, POOL_WIDTH, MEM_WIDTH]).tolist()
    for l in range(DEPTH):
        lambda_init = 0.8 - 0.6 * math.exp(-0.3 * l)
        h = rmsnorm(x, g_attn_norm[l])
        proj = h @ w_in[l]
        qa, ka, va, up, qm, gl = jnp.split(proj, splits, axis=-1)
        qa = partial_rope(rmsnorm(qa.reshape(b, s, DA_HEADS, 2, DA_QK_DIM), g_qa[l]), cos, sin)
        ka = partial_rope(rmsnorm(ka.reshape(b, s, DA_HEADS, 2, DA_QK_DIM), g_ka[l]), cos, sin)
        va = va.reshape(b, s, DA_HEADS, DA_V_DIM)
        lam = (jnp.exp(jnp.sum(lam_q1[l].astype(jnp.float32) * lam_k1[l].astype(jnp.float32)))
               - jnp.exp(jnp.sum(lam_q2[l].astype(jnp.float32) * lam_k2[l].astype(jnp.float32)))
               + lambda_init)
        ya = diff_attention(qa, ka, va, lam, g_subln[l], lambda_init)
        yb = pool_mixer(up, w_pool[l], pool_scale[l])
        yc = mem_attention(qm, mem, g_mem[l], w_mkv[l], g_qm[l], g_km[l])
        gates = jax.nn.sigmoid(gl.reshape(b, s, N_BRANCHES, D_MODEL))
        merged = (gates[:, :, 0] * (ya @ w_a[l]) + gates[:, :, 1] * (yb @ w_b[l])
                  + gates[:, :, 2] * (yc @ w_c[l]))
        x = x + merged @ w_o[l]
        x = x + conv_ffn(rmsnorm(x, g_ffn_norm[l]), w_up[l], conv_w[l], conv_b[l], w_down[l])
    return x
```

```cpp
#include <hip/hip_runtime.h>
#include <cstdio>
#include <cstdint>

#define LAS __attribute__((address_space(3)))
#define GAS __attribute__((address_space(1)))
typedef unsigned short bf16_t;
typedef short bf16x8 __attribute__((ext_vector_type(8)));
typedef short s16x4 __attribute__((ext_vector_type(4)));
typedef float f32x2 __attribute__((ext_vector_type(2)));
typedef float f32x4 __attribute__((ext_vector_type(4)));
typedef float f32x16 __attribute__((ext_vector_type(16)));
typedef unsigned u32x2 __attribute__((ext_vector_type(2)));
typedef unsigned u32x4 __attribute__((ext_vector_type(4)));
typedef __bf16 bf16x2_t __attribute__((ext_vector_type(2)));
typedef int v8i32 __attribute__((ext_vector_type(8)));

constexpr int BATCH = 2, SEQ = 8192, DMODEL = 4096, MTOK = BATCH * SEQ;
constexpr int NIN = 20480, DFF = 11008, NUP = 2 * DFF, MEMLEN = 256, MROWS = BATCH * MEMLEN;
constexpr float EPS = 1e-6f, LOG2E = 1.4426950408889634f;
constexpr float LAMBDA_INIT = 0.2f;
constexpr int NWAVES = 8;

constexpr size_t MiB = 1u << 20;
constexpr size_t WS_CTL = 0, CTL_ZERO_BYTES = 32768;
constexpr size_t WS_WUP = 2 * MiB;
constexpr size_t WS_WDOWN = 174 * MiB;
constexpr size_t WS_WIN = 260 * MiB;
constexpr size_t WS_WG8 = 324 * MiB;
constexpr size_t DO_H8 = 128 * MiB;
constexpr size_t WS_WA = 420 * MiB;
constexpr size_t WS_WB = 436 * MiB;
constexpr size_t WS_WC = 444 * MiB;
constexpr size_t WS_WO = 452 * MiB;
constexpr size_t WS_WMKV = 484 * MiB;
constexpr size_t WS_WPOOL = 500 * MiB;
constexpr size_t WS_KVM = 501 * MiB;
constexpr size_t WS_HM = 503 * MiB;
constexpr size_t WS_QA = 508 * MiB, WS_KA = 572 * MiB, WS_VA = 636 * MiB;
constexpr size_t WS_UP = 700 * MiB, WS_QM = 732 * MiB;
constexpr size_t WS_GL = 764 * MiB;
constexpr size_t WS_YP = 1148 * MiB;
constexpr size_t WS_MERGED = 508 * MiB;
constexpr size_t WS_X1B = 260 * MiB;
constexpr size_t WS_ACT = 852 * MiB;
constexpr size_t WS_SSQ = 1196 * MiB;
constexpr size_t WS_HALO = 1200 * MiB;
constexpr size_t WS_WBF = 960 * MiB;
constexpr size_t WS_WPF = 968 * MiB;
constexpr size_t WS_END = 1222 * MiB;
constexpr size_t DO_YA = 192 * MiB, DO_YB = 128 * MiB, DO_YC = 160 * MiB;
constexpr size_t WS_RS1 = 1 * MiB;

constexpr int CW_TMO = 0;
constexpr int CW_BAR = 4096;
constexpr int CW_P0A = 64;

constexpr int RING_OFF = 0, RING_BYTES = 131072;
constexpr int LDSCTL_OFF = RING_BYTES, MISC_OFF = LDSCTL_OFF + 320;
constexpr int WSF_OFF = RING_BYTES + 1024;
constexpr int XCH_OFF = RING_BYTES + 4096;
constexpr int RSTD_OFF = RING_BYTES + 12288;
constexpr int LDS_BYTES = 155648;

__device__ __forceinline__ float bflo(unsigned w) { return __uint_as_float(w << 16); }
__device__ __forceinline__ float bfhi(unsigned w) { return __uint_as_float(w & 0xffff0000u); }
__device__ __forceinline__ unsigned pk2(float lo, float hi) { f32x2 v = {lo, hi}; bf16x2_t b = __builtin_convertvector(v, bf16x2_t); return __builtin_bit_cast(unsigned, b); }
__device__ __forceinline__ float sigmoidf_fast(float a) { return __builtin_amdgcn_rcpf(1.0f + __builtin_amdgcn_exp2f(-LOG2E * a)); }
template <int K> __device__ __forceinline__ float sx(float v) { return __int_as_float(__builtin_amdgcn_ds_swizzle(__float_as_int(v), (K << 10) | 0x1f)); }
__device__ __forceinline__ float sum32x(float v) { auto rr = __builtin_amdgcn_permlane32_swap(__float_as_uint(v), __float_as_uint(v), false, false); return __uint_as_float(rr[0]) + __uint_as_float(rr[1]); }
__device__ __forceinline__ float max32x(float v) { auto rr = __builtin_amdgcn_permlane32_swap(__float_as_uint(v), __float_as_uint(v), false, false); return fmaxf(__uint_as_float(rr[0]), __uint_as_float(rr[1])); }
__device__ __forceinline__ float wave_sum(float v) { v += sx<1>(v); v += sx<2>(v); v += sx<4>(v); v += sx<8>(v); v += sx<16>(v); return sum32x(v); }
__device__ __forceinline__ float wave_max(float v) { v = fmaxf(v, sx<1>(v)); v = fmaxf(v, sx<2>(v)); v = fmaxf(v, sx<4>(v)); v = fmaxf(v, sx<8>(v)); v = fmaxf(v, sx<16>(v)); return max32x(v); }
__device__ __forceinline__ void unpack8(const u32x4 w, float (&f)[8]) { f[0] = bflo(w.x); f[1] = bfhi(w.x); f[2] = bflo(w.y); f[3] = bfhi(w.y); f[4] = bflo(w.z); f[5] = bfhi(w.z); f[6] = bflo(w.w); f[7] = bfhi(w.w); }
__device__ __forceinline__ unsigned pk4_fp8(float a, float b, float c, float d) { int p = __builtin_amdgcn_cvt_pk_fp8_f32(a, b, 0, false); p = __builtin_amdgcn_cvt_pk_fp8_f32(c, d, p, true); return (unsigned)p; }
__device__ __forceinline__ void gate_unpack8(const u32x2 w, float (&f)[8]) { f[0] = (float)(w.x & 0xffu); f[1] = (float)((w.x >> 8) & 0xffu); f[2] = (float)((w.x >> 16) & 0xffu); f[3] = (float)(w.x >> 24);
                                                                            f[4] = (float)(w.y & 0xffu); f[5] = (float)((w.y >> 8) & 0xffu); f[6] = (float)((w.y >> 16) & 0xffu); f[7] = (float)(w.y >> 24); }
#define LDS_WAIT() asm volatile("s_waitcnt lgkmcnt(0)" ::: "memory")
#define VM_WAIT() asm volatile("s_waitcnt vmcnt(0)" ::: "memory")

namespace pg8 {
constexpr int BM = 256, BK = 64, HALF = 128, HTB = HALF * BK * 2, STAGE_BYTES = 8 * HTB, NXCD = 8, WGM = 8;
__host__ __device__ __forceinline__ int lds_byte(int r, int c) { const int st = (r >> 4) * 2 + (c >> 5), rr = r & 15, cc = c & 31, ob = rr * 64 + cc * 2; return st * 1024 + (ob ^ (((ob >> 9) & 1) << 5)); }
__host__ __device__ __forceinline__ void stage_rc(int b, int& R, int& C) { const int st = b / 1024, sb = b % 1024, swz = sb ^ (((sb >> 9) & 1) << 5); R = (st >> 1) * 16 + swz / 64; C = (st & 1) * 32 + (swz % 64) / 2; }
__host__ __device__ __forceinline__ int lds_byte2(int r, int c) { const int rr = r & 7, q = c >> 3; return (r >> 3) * 1024 + rr * 128 + ((q ^ (((rr >> 1) & 3) << 1)) << 4); }
__host__ __device__ __forceinline__ void stage_rc2(int b, int& R, int& C) { const int blk = b / 1024, sb = b % 1024, rr = sb / 128, pos = (sb % 128) / 16; R = blk * 8 + rr; C = (pos ^ (((rr >> 1) & 3) << 1)) * 8; }
__host__ __device__ __forceinline__ int perm32(int rho) { const int n = rho >> 4, i = rho & 15; return 8 * (i >> 2) + 4 * n + (i & 3); }

struct Unit { int pm, pn; };

struct StaticOrder {
    int nM, nN, nwg, G, c;
    __device__ void init(int M, int N, int G_, int c_) { nM = M / BM; nN = N / BM; nwg = nM * nN; G = G_; c = c_; }
    __device__ bool next(int i, Unit& u) const {
        const long L = (long)i * G + c; if (L >= nwg) return false;
        int wgid = (int)L; { const int q = nwg / NXCD, r = nwg % NXCD, xcd = wgid % NXCD, off = wgid / NXCD; wgid = (xcd < r ? xcd * (q + 1) : r * (q + 1) + (xcd - r) * q) + off; }
        const int nig = WGM * nN, gid = wgid / nig, fm = gid * WGM, gsz = (nM - fm) < WGM ? (nM - fm) : WGM;
        u.pm = fm + ((wgid % nig) % gsz); u.pn = (wgid % nig) / gsz; return true;
    }
};

typedef f32x4 Acc[2][2][4][2];

struct TileOut { bf16_t* base; int ld, colt, mode; const float* g; float scale; };
__device__ __forceinline__ void norm_store(Acc& acc, const Unit& u, const TileOut t, LAS float* xch, const float* inv2pi, int wr, int wc, int fr, int fq) {
    asm volatile("" : "+v"(fq), "+v"(fr));
    const int lrow = wr * 64 + fr;
    if (t.mode >= 2) {
        f32x4 gv[2][2];
#pragma unroll
        for (int bj = 0; bj < 2; ++bj)
#pragma unroll
            for (int n = 0; n < 2; ++n) gv[bj][n] = *(const f32x4*)(t.g + (t.mode == 3 ? bj * HALF : 0) + wc * 32 + 8 * fq + 4 * n);
#pragma unroll
        for (int ai = 0; ai < 2; ++ai)
#pragma unroll
            for (int m = 0; m < 4; ++m)
#pragma unroll
                for (int bj = 0; bj < 2; ++bj) { const f32x4 a = acc[ai][bj][m][0], b = acc[ai][bj][m][1];
                    float q = (a[0] * a[0] + a[1] * a[1]) + (a[2] * a[2] + a[3] * a[3]) + (b[0] * b[0] + b[1] * b[1]) + (b[2] * b[2] + b[3] * b[3]);
                    q += sx<16>(q); q = sum32x(q);
                    if (fq == 0) xch[((lrow + ai * HALF + m * 16) * 2 + bj) * 4 + wc] = q; }
        asm volatile("s_waitcnt lgkmcnt(0)\n\ts_barrier" ::: "memory");
#pragma unroll
        for (int ai = 0; ai < 2; ++ai)
#pragma unroll
            for (int m = 0; m < 4; ++m) {
                const f32x4 p0 = *(const LAS f32x4*)(xch + ((lrow + ai * HALF + m * 16) * 2 + 0) * 4), p1 = *(const LAS f32x4*)(xch + ((lrow + ai * HALF + m * 16) * 2 + 1) * 4);
                const float s0 = (p0[0] + p0[1]) + (p0[2] + p0[3]), s1 = (p1[0] + p1[1]) + (p1[2] + p1[3]);
                float r0, r1;
                if (t.mode == 3) { r0 = r1 = t.scale * __builtin_amdgcn_rsqf((s0 + s1) * (1.f / 256.f) + EPS); } else { r0 = __builtin_amdgcn_rsqf(s0 * (1.f / 128.f) + EPS); r1 = __builtin_amdgcn_rsqf(s1 * (1.f / 128.f) + EPS); }
#pragma unroll
                for (int n = 0; n < 2; ++n) { acc[ai][0][m][n] = acc[ai][0][m][n] * r0 * gv[0][n]; acc[ai][1][m][n] = acc[ai][1][m][n] * r1 * gv[1][n]; } }
        if (t.mode == 2) {
            if (wc == 0) {
                f32x4 iv[2];
#pragma unroll
                for (int n = 0; n < 2; ++n) iv[n] = *(const f32x4*)(inv2pi + 8 * (fq & 1) + 4 * n);
                const float sgn = (fq < 2) ? -1.0f : 1.0f;
#pragma unroll
                for (int ai = 0; ai < 2; ++ai)
#pragma unroll
                    for (int m = 0; m < 4; ++m) { const float fp = (float)((u.pm * BM + lrow + ai * HALF + m * 16) & (SEQ - 1));
#pragma unroll
                        for (int n = 0; n < 2; ++n)
#pragma unroll
                            for (int e = 0; e < 4; ++e) { const float rev = __builtin_amdgcn_fractf(fp * iv[n][e]); const float c = __builtin_amdgcn_cosf(rev), sn = __builtin_amdgcn_sinf(rev) * sgn;
#pragma unroll
                                for (int bj = 0; bj < 2; ++bj) { const float v = acc[ai][bj][m][n][e];
                                    auto rr = __builtin_amdgcn_permlane32_swap(__float_as_uint(v), __float_as_uint(v), false, false);
                                    const float other = __uint_as_float(fq < 2 ? rr[1] : rr[0]);
                                    acc[ai][bj][m][n][e] = v * c + other * sn; } } }
            }
#pragma unroll
            for (int ai = 0; ai < 2; ++ai)
#pragma unroll
                for (int m = 0; m < 4; ++m)
#pragma unroll
                    for (int bj = 0; bj < 2; ++bj)
#pragma unroll
                        for (int n = 0; n < 2; ++n) acc[ai][bj][m][n] = acc[ai][bj][m][n] * t.scale;
        }
    }
    const int row0 = u.pm * BM + lrow, col0 = t.colt + wc * 32 + 8 * fq;
#pragma unroll
    for (int ai = 0; ai < 2; ++ai)
#pragma unroll
        for (int m = 0; m < 4; ++m) { bf16_t* rowp = t.base + (size_t)(row0 + ai * HALF + m * 16) * t.ld + col0;
#pragma unroll
            for (int bj = 0; bj < 2; ++bj) { f32x4 v0 = acc[ai][bj][m][0], v1 = acc[ai][bj][m][1];
                if (t.mode == 1) {
#pragma unroll
                    for (int e = 0; e < 4; ++e) { v0[e] = sigmoidf_fast(v0[e]); v1[e] = sigmoidf_fast(v1[e]); } }
                u32x4 w; w.x = pk2(v0[0], v0[1]); w.y = pk2(v0[2], v0[3]); w.z = pk2(v1[0], v1[1]); w.w = pk2(v1[2], v1[3]);
                *(u32x4*)(rowp + bj * HALF) = w; } }
}
struct EpiProj {
    static constexpr bool PERM = true;
    bf16_t* qa; bf16_t* up; bf16_t* qm; bf16_t* gl;
    const LAS float* rs; int pm_base;
    const float* g_qa; const float* g_ka; const float* g_qm; LAS float* xch; const float* inv2pi;
    __device__ __forceinline__ void operator()(Acc& acc, const Unit& u, int wr, int wc, int fr, int fq) const {
        { const LAS float* rp = rs + (u.pm - pm_base) * BM + wr * 64 + fr; float r8[8];
#pragma unroll
          for (int i = 0; i < 8; ++i) r8[i] = rp[(i >> 2) * HALF + (i & 3) * 16];
#pragma unroll
          for (int ai = 0; ai < 2; ++ai)
#pragma unroll
              for (int m = 0; m < 4; ++m)
#pragma unroll
                  for (int bj = 0; bj < 2; ++bj)
#pragma unroll
                      for (int n = 0; n < 2; ++n) acc[ai][bj][m][n] *= r8[ai * 4 + m]; }
        const int pn = u.pn; TileOut t;
        if (pn < 8) { t.base = qa; t.ld = 2048; t.colt = pn * 256; t.mode = 2; t.g = g_qa; t.scale = 0.08838834764831845f * LOG2E; }
        else if (pn < 16) { t.base = qa + (size_t)MTOK * 2048; t.ld = 2048; t.colt = (pn - 8) * 256; t.mode = 2; t.g = g_ka; t.scale = 1.0f; }
        else if (pn < 24) { t.base = qa + (size_t)2 * MTOK * 2048; t.ld = 2048; t.colt = (pn - 16) * 256; t.mode = 0; t.g = nullptr; t.scale = 1.0f; }
        else if (pn < 28) { t.base = up; t.ld = 1024; t.colt = (pn - 24) * 256; t.mode = 0; t.g = nullptr; t.scale = 1.0f; }
        else if (pn < 32) { t.base = qm; t.ld = 1024; t.colt = (pn - 28) * 256; t.mode = 3; t.g = g_qm; t.scale = 0.0625f * LOG2E; }
        else { t.base = gl; t.ld = 12288; t.colt = (pn - 32) * 256; t.mode = 1; t.g = nullptr; t.scale = 1.0f; }
        norm_store(acc, u, t, xch, inv2pi, wr, wc, fr, fq);
    }
};
struct EpiG8 {
    static constexpr bool PERM = true;
    unsigned char* gl; bf16_t* qm; const float* g_qm; LAS float* xch;
    __device__ __forceinline__ void operator()(Acc& acc, const Unit& u, int wr, int wc, int fr, int fq) const {
        if (u.pn < 4) {
#pragma unroll
            for (int ai = 0; ai < 2; ++ai)
#pragma unroll
                for (int bj = 0; bj < 2; ++bj)
#pragma unroll
                    for (int m = 0; m < 4; ++m)
#pragma unroll
                        for (int n = 0; n < 2; ++n) acc[ai][bj][m][n] = acc[ai][bj][m][n] * 0.015625f;
            TileOut t; t.base = qm; t.ld = 1024; t.colt = u.pn * 256; t.mode = 3; t.g = g_qm; t.scale = 0.0625f * LOG2E;
            norm_store(acc, u, t, xch, nullptr, wr, wc, fr, fq);
            return;
        }
        unsigned char* tp = gl + ((size_t)(u.pm * 48 + (u.pn - 4)) << 16) + (wr * 4 + wc) * 8192 + (fq * 16 + fr) * 16;
#pragma unroll
        for (int ai = 0; ai < 2; ++ai)
#pragma unroll
            for (int m = 0; m < 4; ++m) { u32x4 w4;
#pragma unroll
                for (int bj = 0; bj < 2; ++bj) { const f32x4 v0 = acc[ai][bj][m][0], v1 = acc[ai][bj][m][1];
                    unsigned lo = 0u, hi = 0u;
#pragma unroll
                    for (int e = 0; e < 4; ++e) {
                        const float q0 = __builtin_amdgcn_rcpf((1.0f / 255.0f) + __builtin_amdgcn_exp2f(__builtin_fmaf(v0[e], -LOG2E * 0.015625f, -7.99435343685886f)));
                        const float q1 = __builtin_amdgcn_rcpf((1.0f / 255.0f) + __builtin_amdgcn_exp2f(__builtin_fmaf(v1[e], -LOG2E * 0.015625f, -7.99435343685886f)));
                        lo = __builtin_amdgcn_cvt_pk_u8_f32(fmaxf(q0 + 0.5f, 1.0f), e, lo); hi = __builtin_amdgcn_cvt_pk_u8_f32(fmaxf(q1 + 0.5f, 1.0f), e, hi); }
                    if (bj == 0) { w4.x = lo; w4.y = hi; } else { w4.z = lo; w4.w = hi; } }
                *(u32x4*)(tp + (ai * 4 + m) * 1024) = w4; }
    }
};
struct EpiKvm {
    static constexpr bool PERM = true;
    bf16_t* kvm; const float* g_km; LAS float* xch;
    __device__ __forceinline__ void operator()(Acc& acc, const Unit& u, int wr, int wc, int fr, int fq) const {
        TileOut t; t.base = kvm; t.ld = 2048; t.colt = u.pn * 256; t.mode = (u.pn < 4) ? 3 : 0; t.g = g_km; t.scale = 1.0f;
        norm_store(acc, u, t, xch, nullptr, wr, wc, fr, fq);
    }
};
struct EpiBf16 {
    static constexpr bool PERM = true;
    bf16_t* O; int ldc; const float* colscale;
    __device__ __forceinline__ void operator()(const Acc& acc, const Unit& u, int wr, int wc, int fr, int fq) const {
        const int row0 = u.pm * BM + wr * 64 + fr, col0 = u.pn * BM + wc * 32 + 8 * fq;
        f32x4 sv[2][2];
#pragma unroll
        for (int bj = 0; bj < 2; ++bj)
#pragma unroll
            for (int n = 0; n < 2; ++n) sv[bj][n] = colscale ? *(const f32x4*)(colscale + col0 + bj * HALF + 4 * n) : (f32x4){1.f, 1.f, 1.f, 1.f};
#pragma unroll
        for (int ai = 0; ai < 2; ++ai)
#pragma unroll
            for (int m = 0; m < 4; ++m) { bf16_t* rowp = O + (size_t)(row0 + ai * HALF + m * 16) * ldc + col0;
#pragma unroll
                for (int bj = 0; bj < 2; ++bj) { const f32x4 v0 = acc[ai][bj][m][0] * sv[bj][0], v1 = acc[ai][bj][m][1] * sv[bj][1];
                    u32x4 w; w.x = pk2(v0[0], v0[1]); w.y = pk2(v0[2], v0[3]); w.z = pk2(v1[0], v1[1]); w.w = pk2(v1[2], v1[3]);
                    *(u32x4*)(rowp + bj * HALF) = w; } }
    }
};
struct EpiMerge {
    static constexpr bool PERM = true;
    bf16_t* O; const unsigned char* gate;
    __device__ __forceinline__ void mid(Acc& acc, const Unit& u, int s, int wr, int wc, int fr, int fq) const {
        int lo = (wr * 4 + wc) * 8192 + (fq * 16 + fr) * 16; asm volatile("" : "+v"(lo));
        const unsigned char* gp = gate + ((size_t)(u.pm * 48 + s * 16 + u.pn) << 16) + lo;
        u32x4 G[8][2];
#pragma unroll
        for (int i = 0; i < 8; ++i) { G[i][0] = __builtin_nontemporal_load((const u32x4*)(gp + i * 1024)); G[i][1] = __builtin_nontemporal_load((const u32x4*)(gp + (1 << 20) + i * 1024)); }
#pragma unroll
        for (int i = 0; i < 8; ++i) { const int ai = i >> 2, m = i & 3;
#pragma unroll
            for (int bj = 0; bj < 2; ++bj) {
                const u32x4 ga = G[i][0], gb = G[i][1];
                const u32x2 wa = bj == 0 ? (u32x2){ga.x, ga.y} : (u32x2){ga.z, ga.w}, wb = bj == 0 ? (u32x2){gb.x, gb.y} : (u32x2){gb.z, gb.w};
                float fa[8], fb[8]; gate_unpack8(wa, fa); gate_unpack8(wb, fb);
#pragma unroll
                for (int e = 0; e < 8; ++e) fa[e] = fa[e] * __builtin_amdgcn_rcpf(fb[e]);
                f32x4& v0 = acc[ai][bj][m][0]; f32x4& v1 = acc[ai][bj][m][1];
                v0[0] *= fa[0]; v0[1] *= fa[1]; v0[2] *= fa[2]; v0[3] *= fa[3]; v1[0] *= fa[4]; v1[1] *= fa[5]; v1[2] *= fa[6]; v1[3] *= fa[7]; }
            __builtin_amdgcn_sched_barrier(0); }
    }
    __device__ __forceinline__ void operator()(const Acc& acc, const Unit& u, int wr, int wc, int fr, int fq) const {
        const int row0 = u.pm * BM + wr * 64 + fr, col0 = u.pn * BM + wc * 32 + 8 * fq;
        const unsigned char* gp = gate + ((size_t)(u.pm * 48 + 32 + u.pn) << 16) + (wr * 4 + wc) * 8192 + (fq * 16 + fr) * 16;
        u32x4 G2[8];
#pragma unroll
        for (int i = 0; i < 8; ++i) G2[i] = __builtin_nontemporal_load((const u32x4*)(gp + i * 1024));
        __builtin_amdgcn_sched_barrier(0);
#pragma unroll
        for (int ai = 0; ai < 2; ++ai)
#pragma unroll
            for (int m = 0; m < 4; ++m) { const size_t r = (size_t)(row0 + ai * HALF + m * 16);
                const u32x4 g4 = G2[ai * 4 + m];
#pragma unroll
                for (int bj = 0; bj < 2; ++bj) {
                    const u32x2 gw = bj == 0 ? (u32x2){g4.x, g4.y} : (u32x2){g4.z, g4.w};
                    float fg[8]; gate_unpack8(gw, fg);
#pragma unroll
                    for (int e = 0; e < 8; ++e) fg[e] *= (1.0f / 255.0f);
                    const f32x4 v0 = acc[ai][bj][m][0], v1 = acc[ai][bj][m][1];
                    u32x4 w; w.x = pk2(v0[0] * fg[0], v0[1] * fg[1]); w.y = pk2(v0[2] * fg[2], v0[3] * fg[3]); w.z = pk2(v1[0] * fg[4], v1[1] * fg[5]); w.w = pk2(v1[2] * fg[6], v1[3] * fg[7]);
                    *(u32x4*)(O + r * 4096 + col0 + bj * HALF) = w; } }
    }
};
struct EpiX1 {
    static constexpr bool PERM = true;
    const bf16_t* base; bf16_t* xb; float* ssq;
    __device__ __forceinline__ void operator()(const Acc& acc, const Unit& u, int wr, int wc, int fr, int fq) const {
        const int row0 = u.pm * BM + wr * 64 + fr, col0 = u.pn * BM + wc * 32 + 8 * fq;
        u32x4 X[8];
#define X1_LOAD(slot, s_) X[slot] = __builtin_nontemporal_load((const u32x4*)(base + (size_t)(row0 + ((s_) >> 3) * HALF + (((s_) >> 1) & 3) * 16) * DMODEL + col0 + ((s_) & 1) * HALF))
#pragma unroll
        for (int s_ = 0; s_ < 8; ++s_) X1_LOAD(s_, s_);
        __builtin_amdgcn_sched_barrier(0);
        float q = 0.f;
#pragma unroll
        for (int s_ = 0; s_ < 16; ++s_) { const int ai = s_ >> 3, m = (s_ >> 1) & 3, bj = s_ & 1;
            const int row = row0 + ai * HALF + m * 16; const size_t off = (size_t)row * DMODEL + col0;
            const u32x4 rw = X[s_ & 7];
            if (s_ + 8 < 16) X1_LOAD(s_ & 7, s_ + 8);
            f32x4 v0 = acc[ai][bj][m][0], v1 = acc[ai][bj][m][1];
            v0[0] += bflo(rw.x); v0[1] += bfhi(rw.x); v0[2] += bflo(rw.y); v0[3] += bfhi(rw.y); v1[0] += bflo(rw.z); v1[1] += bfhi(rw.z); v1[2] += bflo(rw.w); v1[3] += bfhi(rw.w);
            u32x4 w; w.x = pk2(v0[0], v0[1]); w.y = pk2(v0[2], v0[3]); w.z = pk2(v1[0], v1[1]); w.w = pk2(v1[2], v1[3]); *(u32x4*)(xb + off + bj * HALF) = w;
            q += ((v0[0] * v0[0] + v0[1] * v0[1]) + (v0[2] * v0[2] + v0[3] * v0[3])) + ((v1[0] * v1[0] + v1[1] * v1[1]) + (v1[2] * v1[2] + v1[3] * v1[3]));
            if (bj == 1) { q += sx<16>(q); q = sum32x(q);
                if (fq == 0) ssq[(size_t)row * 64 + u.pn * 4 + wc] = q;
                q = 0.f; }
            __builtin_amdgcn_sched_barrier(0); }
#undef X1_LOAD
    }
};
struct EpiOut {
    static constexpr bool PERM = true;
    const bf16_t* resid; float* out;
    __device__ __forceinline__ void operator()(const Acc& acc, const Unit& u, int wr, int wc, int fr, int fq) const {
        const int row0 = u.pm * BM + wr * 64 + fr, col0 = u.pn * BM + wc * 32 + 8 * fq;
        u32x4 R[16];
#pragma unroll
        for (int s_ = 0; s_ < 16; ++s_) R[s_] = __builtin_nontemporal_load((const u32x4*)(resid + (size_t)(row0 + (s_ >> 3) * HALF + ((s_ >> 1) & 3) * 16) * DMODEL + col0 + (s_ & 1) * HALF));
        __builtin_amdgcn_sched_barrier(0);
#pragma unroll
        for (int ai = 0; ai < 2; ++ai)
#pragma unroll
            for (int m = 0; m < 4; ++m) { const size_t off = (size_t)(row0 + ai * HALF + m * 16) * DMODEL + col0;
#pragma unroll
                for (int bj = 0; bj < 2; ++bj) { const u32x4 rw = R[(ai * 4 + m) * 2 + bj];
                    f32x4 o0 = acc[ai][bj][m][0], o1 = acc[ai][bj][m][1];
                    o0[0] += bflo(rw.x); o0[1] += bfhi(rw.x); o0[2] += bflo(rw.y); o0[3] += bfhi(rw.y); o1[0] += bflo(rw.z); o1[1] += bfhi(rw.z); o1[2] += bflo(rw.w); o1[3] += bfhi(rw.w);
                    *(f32x4*)(out + off + bj * HALF) = o0; *(f32x4*)(out + off + bj * HALF + 4) = o1; } }
    }
};
template <int CTRL> __device__ __forceinline__ float dpp_f(float old, float src) { return __int_as_float(__builtin_amdgcn_update_dpp(__float_as_int(old), __float_as_int(src), CTRL, 0xf, 0xf, false)); }
template <int CTRL> __device__ __forceinline__ float dppz_f(float src) { return __int_as_float(__builtin_amdgcn_update_dpp(0, __float_as_int(src), CTRL, 0xf, 0xf, true)); }
struct EpiUpConv {
    static constexpr bool PERM = true;
    bf16_t* act; const float* conv_w; const float* conv_b; float* halo; LAS f32x4* xch; const LAS float* rstd; int pm_base;
    __device__ __forceinline__ void operator()(Acc& acc, const Unit& u, int wr, int wc, int fr, int fq) const {
        const int ch = u.pn * 128 + wc * 32 + 8 * fq;
        const LAS float* rs = rstd + (u.pm - pm_base) * 256 + wr * 64 + fr;
#pragma unroll
        for (int ai = 0; ai < 2; ++ai)
#pragma unroll
            for (int m = 0; m < 4; ++m) { const float r = rs[ai * HALF + m * 16];
#pragma unroll
                for (int bj = 0; bj < 2; ++bj)
#pragma unroll
                    for (int n = 0; n < 2; ++n) acc[ai][bj][m][n] *= r; }
        f32x4 CW[2][4];
#define CW_LOAD(buf, g) do { const int col_ = ((g) >> 1) * DFF + ch + 4 * ((g) & 1); \
            CW[buf][0] = *(const f32x4*)(conv_w + col_); CW[buf][1] = *(const f32x4*)(conv_w + NUP + col_); CW[buf][2] = *(const f32x4*)(conv_w + 2 * NUP + col_); CW[buf][3] = *(const f32x4*)(conv_b + col_); } while (0)
        CW_LOAD(0, 0);
        if (fr >= 14) {
#pragma unroll
            for (int ai = 0; ai < 2; ++ai)
#pragma unroll
                for (int bj = 0; bj < 2; ++bj)
#pragma unroll
                    for (int n = 0; n < 2; ++n) xch[((((ai * 2 + wr) * 4 + wc) * 2 + (fr - 14)) * 4 + fq) * 4 + bj * 2 + n] = acc[ai][bj][3][n];
        }
        if (wr == 0 && fr < 2) {
#pragma unroll
            for (int bj = 0; bj < 2; ++bj)
#pragma unroll
                for (int n = 0; n < 2; ++n) *(f32x4*)(halo + (size_t)(u.pm * 4 + fr) * NUP + bj * DFF + ch + 4 * n) = acc[0][bj][0][n];
        }
        if (wr == 1 && fr >= 14) {
#pragma unroll
            for (int bj = 0; bj < 2; ++bj)
#pragma unroll
                for (int n = 0; n < 2; ++n) *(f32x4*)(halo + (size_t)(u.pm * 4 + 2 + (fr - 14)) * NUP + bj * DFF + ch + 4 * n) = acc[1][bj][3][n];
        }
        asm volatile("s_waitcnt lgkmcnt(0)\n\ts_barrier" ::: "memory");
#pragma unroll
        for (int bj = 0; bj < 2; ++bj)
#pragma unroll
            for (int n = 0; n < 2; ++n) {
                const int gi = bj * 2 + n;
                if (gi + 1 < 4) CW_LOAD((gi + 1) & 1, gi + 1);
                const f32x4 w0 = CW[gi & 1][0], w1 = CW[gi & 1][1], w2 = CW[gi & 1][2], bb = CW[gi & 1][3];
                const f32x4 w1z = (fr == 0) ? w1 : (f32x4){0.f, 0.f, 0.f, 0.f}, w0z = (fr < 2) ? w0 : (f32x4){0.f, 0.f, 0.f, 0.f};
#pragma unroll
                for (int ai = 0; ai < 2; ++ai) {
                    const bool has = (wr == 1) || (ai == 1);
                    const int pai = (wr == 1) ? ai : 0, pwr = (wr == 1) ? 0 : 1;
                    f32x4 P = (f32x4){0.f, 0.f, 0.f, 0.f};
                    if (has && fr >= 14) P = xch[((((pai * 2 + pwr) * 4 + wc) * 2 + (fr - 14)) * 4 + fq) * 4 + bj * 2 + n];
#pragma unroll
                    for (int m = 3; m >= 0; --m) {
                        const f32x4 cur = acc[ai][bj][m][n]; const f32x4 prv = (m > 0) ? acc[ai][bj][m - 1][n] : P; f32x4 y;
#pragma unroll
                        for (int e = 0; e < 4; ++e) {
                            float t = w2[e] * cur[e] + bb[e];
                            asm("v_fmac_f32_dpp %0, %1, %2 row_shr:1 row_mask:0xf bank_mask:0xf bound_ctrl:1" : "+v"(t) : "v"(cur[e]), "v"(w1[e]));
                            asm("v_fmac_f32_dpp %0, %1, %2 row_shr:2 row_mask:0xf bank_mask:0xf bound_ctrl:1" : "+v"(t) : "v"(cur[e]), "v"(w0[e]));
                            asm("v_fmac_f32_dpp %0, %1, %2 row_ror:1 row_mask:0xf bank_mask:0xf" : "+v"(t) : "v"(prv[e]), "v"(w1z[e]));
                            asm("v_fmac_f32_dpp %0, %1, %2 row_ror:2 row_mask:0xf bank_mask:0xf" : "+v"(t) : "v"(prv[e]), "v"(w0z[e]));
                            y[e] = t; }
                        acc[ai][bj][m][n] = y; } }
                asm volatile("" ::: "memory");
#pragma unroll
                for (int ai = 0; ai < 2; ++ai)
#pragma unroll
                    for (int m = 0; m < 4; ++m) asm volatile("" : "+v"(acc[ai][bj][m][n]));
            }
#undef CW_LOAD
        const int row0 = u.pm * BM + wr * 64 + fr;
#pragma unroll
        for (int ai = 0; ai < 2; ++ai)
#pragma unroll
            for (int m = 0; m < 4; ++m) { f32x4 y0, y1;
#pragma unroll
                for (int e = 0; e < 4; ++e) { const float g0 = acc[ai][0][m][0][e], g1 = acc[ai][0][m][1][e];
                    y0[e] = g0 * sigmoidf_fast(g0) * acc[ai][1][m][0][e]; y1[e] = g1 * sigmoidf_fast(g1) * acc[ai][1][m][1][e]; }
                u32x4 w; w.x = pk2(y0[0], y0[1]); w.y = pk2(y0[2], y0[3]); w.z = pk2(y1[0], y1[1]); w.w = pk2(y1[2], y1[3]);
                *(u32x4*)(act + (size_t)(row0 + ai * HALF + m * 16) * DFF + ch) = w; }
    }
};

struct Seg { const char* A; const char* B; int lda, ldb, nt; };
struct Gemm1 {
    static constexpr int NSEG = 1; static constexpr bool FP8 = false, UNIFORM = true;
    const bf16_t* A; const bf16_t* Bt; int lda, ldb, K, a_pn_off;
    __device__ __forceinline__ Seg seg(const Unit& u, int) const { Seg s; s.A = (const char*)(A + (size_t)u.pm * BM * lda + (size_t)u.pn * a_pn_off); s.B = (const char*)(Bt + (size_t)u.pn * BM * ldb); s.lda = lda; s.ldb = ldb; s.nt = K / BK; return s; }
};
struct Gemm8 {
    static constexpr int NSEG = 1; static constexpr bool FP8 = true, UNIFORM = true;
    const unsigned char* A; const unsigned char* Bt; int kbytes;
    __device__ __forceinline__ Seg seg(const Unit& u, int) const { Seg s; s.A = (const char*)(A + (size_t)u.pm * BM * kbytes); s.B = (const char*)(Bt + (size_t)u.pn * BM * kbytes); s.lda = kbytes / 2; s.ldb = kbytes / 2; s.nt = kbytes / 128; return s; }
};
struct Gemm3 {
    static constexpr int NSEG = 3; static constexpr bool FP8 = false, UNIFORM = false;
    const bf16_t* A[3]; const bf16_t* Bt[3]; int K[3];
    __device__ __forceinline__ Seg seg(const Unit& u, int i) const { const bf16_t* a = i == 0 ? A[0] : (i == 1 ? A[1] : A[2]); const bf16_t* b = i == 0 ? Bt[0] : (i == 1 ? Bt[1] : Bt[2]); const int k = i == 0 ? K[0] : (i == 1 ? K[1] : K[2]);
        Seg s; s.A = (const char*)(a + (size_t)u.pm * BM * k); s.B = (const char*)(b + (size_t)u.pn * BM * k); s.lda = k; s.ldb = k; s.nt = k / BK; return s; }
};

template <class Epi, class Sched, class GemmT>
__device__ __forceinline__ void gemm_phase(LAS unsigned char* lds, const GemmT& g, const Sched& S, const Epi& E, const int wid) {
    int lane = (int)__builtin_amdgcn_mbcnt_hi(~0u, __builtin_amdgcn_mbcnt_lo(~0u, 0u)); asm volatile("" : "+v"(lane));
    const int tid = wid * 64 + lane, wr = wid >> 2, wc = wid & 3, fr = lane & 15, fq = lane >> 4;
    constexpr int NSEG = GemmT::NSEG;
    int RA[2], RB[2], CC[2];
#pragma unroll
    for (int i = 0; i < 2; ++i) { int R, C; stage_rc2(tid * 16 + i * 8192, R, C); RA[i] = R; RB[i] = Epi::PERM ? ((R & ~31) + perm32(R & 31)) : R; CC[i] = C; }
    const size_t kstep = (size_t)(BK * 2);
    const unsigned ldsw = (unsigned)wid * 1024u;
    const int aoffk[2] = {lds_byte2(wr * 64 + fr, fq * 8), lds_byte2(wr * 64 + fr, 32 + fq * 8)}, boffk[2] = {lds_byte2(wc * 32 + fr, fq * 8), lds_byte2(wc * 32 + fr, 32 + fq * 8)};
#define PG8_SA(b, h) (((b) * 2 + (h)) * HTB)
#define PG8_SB(b, h) ((4 + (b) * 2 + (h)) * HTB)
#define PG8_STAGE(bufoff, gbase, voff) do { _Pragma("unroll") for (int _i = 0; _i < 2; ++_i) \
        __builtin_amdgcn_global_load_lds((const unsigned*)((const char*)(gbase) + (voff)[_i]), (LAS unsigned*)(lds + (bufoff) + ldsw + _i * 8192), 16, 0, 0); } while (0)
#define PG8_LDA(dst, b, h) do { _Pragma("unroll") for (int m = 0; m < 4; ++m) _Pragma("unroll") for (int k = 0; k < 2; ++k) dst[m][k] = *(const LAS bf16x8*)(lds + PG8_SA(b, h) + aoffk[k] + m * 2048); } while (0)
#define PG8_LDB(dst, b, h) do { _Pragma("unroll") for (int n = 0; n < 2; ++n) _Pragma("unroll") for (int k = 0; k < 2; ++k) dst[n][k] = *(const LAS bf16x8*)(lds + PG8_SB(b, h) + boffk[k] + n * 2048); } while (0)
#define PG8_CAT(x) __builtin_bit_cast(v8i32, __builtin_shufflevector(x[0], x[1], 0, 1, 2, 3, 4, 5, 6, 7, 8, 9, 10, 11, 12, 13, 14, 15))
#define PG8_MMA(ai, bj, At, Bt) do { __builtin_amdgcn_s_setprio(1); _Pragma("unroll") for (int m = 0; m < 4; ++m) _Pragma("unroll") for (int n = 0; n < 2; ++n) { \
        if constexpr (GemmT::FP8) asm("v_mfma_scale_f32_16x16x128_f8f6f4 %0, %1, %2, %0, %3, %3 op_sel_hi:[0,0,0]" : "+v"(acc[ai][bj][m][n]) : "v"(PG8_CAT(Bt[n])), "v"(PG8_CAT(At[m])), "v"(sc8));     \
        else { _Pragma("unroll") for (int k = 0; k < 2; ++k) acc[ai][bj][m][n] = __builtin_amdgcn_mfma_f32_16x16x32_bf16(Bt[n][k], At[m][k], acc[ai][bj][m][n], 0, 0, 0); } } __builtin_amdgcn_s_setprio(0); } while (0)
#define PG8_WAIT_V(n) asm volatile("s_waitcnt vmcnt(" #n ")" ::: "memory")
#define PG8_WAIT_L(n) asm volatile("s_waitcnt lgkmcnt(" #n ")" ::: "memory")
#define PG8_BAR __builtin_amdgcn_s_barrier()
#define PG8_SCHED __builtin_amdgcn_sched_barrier(0)
#define PG8_VOFFS(vA, vB, hA, hB, sg) do { _Pragma("unroll") for (int _i = 0; _i < 2; ++_i) { vA[_i] = (unsigned)(RA[_i] * (sg).lda + CC[_i]) * 2u; vB[_i] = (unsigned)(RB[_i] * (sg).ldb + CC[_i]) * 2u; } \
        hA = (size_t)HALF * (sg).lda * 2; hB = (size_t)HALF * (sg).ldb * 2; } while (0)
    Unit cur, nxt; int ui = 0;
    if (!S.next(0, cur)) return;
    Acc acc;
#pragma unroll
    for (int a = 0; a < 2; ++a)
#pragma unroll
        for (int b = 0; b < 2; ++b)
#pragma unroll
            for (int m = 0; m < 4; ++m)
#pragma unroll
                for (int n = 0; n < 2; ++n) acc[a][b][m][n] = (f32x4){0.f, 0.f, 0.f, 0.f};
    bf16x8 At[4][2], B0[2][2], B1[2][2];
    const int sc8 = 0x7f7f7f7f; (void)sc8;
    Seg cs = g.seg(cur, 0);
    unsigned voffA[2], voffB[2]; size_t hstepA, hstepB;
    PG8_VOFFS(voffA, voffB, hstepA, hstepB, cs);
    const char* cA = cs.A; const char* cB = cs.B;
    PG8_STAGE(PG8_SB(0, 0), cB, voffB); PG8_STAGE(PG8_SB(0, 1), cB + hstepB, voffB); PG8_STAGE(PG8_SA(0, 0), cA, voffA); PG8_STAGE(PG8_SA(0, 1), cA + hstepA, voffA);
    if (wr == 1) PG8_BAR;
    PG8_WAIT_V(2); PG8_BAR;
    PG8_STAGE(PG8_SB(1, 0), cB + kstep, voffB); PG8_STAGE(PG8_SA(1, 0), cA + kstep, voffA); PG8_STAGE(PG8_SB(1, 1), cB + hstepB + kstep, voffB);
    PG8_WAIT_V(6); PG8_BAR;
    for (;;) {
        const bool has_next = S.next(ui + 1, nxt);
#pragma unroll 1
        for (int sgi = 0; sgi < NSEG; ++sgi) {
            const Seg ns = (sgi + 1 < NSEG) ? g.seg(cur, sgi + 1) : g.seg(has_next ? nxt : cur, 0);
            unsigned nvA[2], nvB[2]; size_t nhA, nhB;
            if constexpr (GemmT::UNIFORM) { nvA[0] = voffA[0]; nvA[1] = voffA[1]; nvB[0] = voffB[0]; nvB[1] = voffB[1]; nhA = hstepA; nhB = hstepB; }
            else PG8_VOFFS(nvA, nvB, nhA, nhB, ns);
            const int nt = cs.nt;
            for (int t = 0; t < nt; t += 2) {
                const bool last = (t == nt - 2);
                const char* a1 = cA + (size_t)(t + 1) * kstep;
                const char* a2 = last ? ns.A : cA + (size_t)(t + 2) * kstep; const char* b2 = last ? ns.B : cB + (size_t)(t + 2) * kstep;
                const char* a3 = a2 + kstep; const char* b3 = b2 + kstep;
                unsigned vA2[2], vB2[2];
#pragma unroll
                for (int i = 0; i < 2; ++i) { vA2[i] = last ? nvA[i] : voffA[i]; vB2[i] = last ? nvB[i] : voffB[i]; }
                const size_t hA2 = last ? nhA : hstepA, hB2 = last ? nhB : hstepB;
                PG8_LDB(B0, 0, 0); PG8_LDB(B1, 0, 1); PG8_SCHED; PG8_LDA(At, 0, 0); PG8_STAGE(PG8_SA(1, 1), a1 + hstepA, voffA);
                PG8_WAIT_V(8); PG8_WAIT_L(0); PG8_BAR; PG8_MMA(0, 0, At, B0); PG8_MMA(0, 1, At, B1); PG8_BAR; PG8_SCHED;
                PG8_LDA(At, 0, 1); PG8_STAGE(PG8_SB(0, 0), b2, vB2); PG8_STAGE(PG8_SB(0, 1), b2 + hB2, vB2); PG8_STAGE(PG8_SA(0, 0), a2, vA2);
                PG8_WAIT_V(8); PG8_WAIT_L(0); PG8_BAR; PG8_MMA(1, 0, At, B0); PG8_MMA(1, 1, At, B1); PG8_BAR; PG8_SCHED;
                PG8_LDB(B0, 1, 0); PG8_LDB(B1, 1, 1); PG8_SCHED; PG8_LDA(At, 1, 0); PG8_STAGE(PG8_SA(0, 1), a2 + hA2, vA2);
                PG8_WAIT_V(8); PG8_WAIT_L(0); PG8_BAR; PG8_MMA(0, 0, At, B0); PG8_MMA(0, 1, At, B1); PG8_BAR; PG8_SCHED;
                PG8_LDA(At, 1, 1); PG8_STAGE(PG8_SB(1, 0), b3, vB2); PG8_STAGE(PG8_SB(1, 1), b3 + hB2, vB2); PG8_STAGE(PG8_SA(1, 0), a3, vA2);
                PG8_WAIT_V(8); PG8_WAIT_L(0); PG8_BAR; PG8_MMA(1, 0, At, B0); PG8_MMA(1, 1, At, B1); PG8_BAR; PG8_SCHED;
            }
            if constexpr (NSEG > 1) { if (sgi + 1 < NSEG) E.mid(acc, cur, sgi, wr, wc, fr, fq); }
            cs = ns; cA = ns.A; cB = ns.B; hstepA = nhA; hstepB = nhB;
#pragma unroll
            for (int i = 0; i < 2; ++i) { voffA[i] = nvA[i]; voffB[i] = nvB[i]; }
        }
        if (wr == 0) PG8_BAR;
        if constexpr (GemmT::FP8) asm volatile("s_nop 15\n\ts_nop 15" ::: "memory");
        E(acc, cur, wr, wc, fr, fq);
        if (!has_next) break;
#pragma unroll
        for (int a = 0; a < 2; ++a)
#pragma unroll
            for (int b = 0; b < 2; ++b)
#pragma unroll
                for (int m = 0; m < 4; ++m)
#pragma unroll
                    for (int n = 0; n < 2; ++n) acc[a][b][m][n] = (f32x4){0.f, 0.f, 0.f, 0.f};
        cur = nxt; ++ui;
        if (wr == 1) PG8_BAR;
    }
    PG8_WAIT_V(0);
    PG8_BAR;
#undef PG8_SA
#undef PG8_SB
#undef PG8_STAGE
#undef PG8_LDA
#undef PG8_LDB
#undef PG8_MMA
#undef PG8_CAT
#undef PG8_WAIT_V
#undef PG8_WAIT_L
#undef PG8_BAR
#undef PG8_SCHED
#undef PG8_VOFFS
}
}

namespace att {
constexpr int SLOTB = 65536, K_OFF = 0, V_OFF = 32768;
__device__ __forceinline__ void glds16s(unsigned voff, const void* sbase, unsigned lds_dst) { unsigned keep;
    asm volatile("s_mov_b32 %0, m0\n\ts_mov_b32 m0, %3\n\ts_nop 0\n\tglobal_load_lds_dwordx4 %1, %2\n\ts_mov_b32 m0, %0" : "=&s"(keep) : "v"(voff), "s"(sbase), "s"(lds_dst) : "memory"); }
__device__ __forceinline__ void glds16s_nc(unsigned voff, const void* sbase, unsigned lds_dst) { unsigned keep;
    asm volatile("s_mov_b32 %0, m0\n\ts_mov_b32 m0, %3\n\ts_nop 0\n\tglobal_load_lds_dwordx4 %1, %2\n\ts_mov_b32 m0, %0" : "=&s"(keep) : "v"(voff), "s"(sbase), "s"(lds_dst)); }
typedef short v4i16_t __attribute__((ext_vector_type(4)));
__device__ __forceinline__ s16x4 vtr(const LAS unsigned char* p) { return __builtin_bit_cast(s16x4, __builtin_amdgcn_ds_read_tr16_b64_v4i16((LAS v4i16_t*)p)); }
#define ATT_WAIT_BAR() asm volatile("s_waitcnt vmcnt(0) lgkmcnt(0)\n\ts_barrier" ::: "memory")

#define ATT_SB() __builtin_amdgcn_sched_barrier(0)
__device__ __forceinline__ void rowbuf_put(LAS unsigned char* buf, int fr, int fq, int qh, int db, u32x2 w) {
    const int row = 16 * qh + fr; *(LAS u32x2*)(buf + row * 512 + (((2 * db + (fq >> 1)) ^ (row & 15)) << 4) + (fq & 1) * 8) = w; }
template <int NROWS>
__device__ __forceinline__ void rowbuf_store(const LAS unsigned char* buf, int lane, bf16_t* gdst, int pitch) {
    asm volatile("s_waitcnt lgkmcnt(0)" ::: "memory");
    bf16_t* dst = gdst + (size_t)(lane >> 5) * pitch + (lane & 31) * 8;
#pragma unroll
    for (int i = 0; i < NROWS / 2; ++i) { const int row = 2 * i + (lane >> 5);
        const u32x4 v = *(const LAS u32x4*)(buf + row * 512 + (((lane & 31) ^ (row & 15)) << 4)); *(u32x4*)(dst + (size_t)(2 * i) * pitch) = v; }
}

__device__ __forceinline__ void attn_core16(f32x4 (&O)[16][2], float (&lq)[2], const bf16_t* Qw, int q_pitch, const bf16_t* Kh, const bf16_t* Vh, int kv_pitch,
                                            int NT, int nt_act, int kch0, float negb, LAS unsigned char* ring, int wid) {
    int lane = (int)__builtin_amdgcn_mbcnt_hi(~0u, __builtin_amdgcn_mbcnt_lo(~0u, 0u)); asm volatile("" : "+v"(lane));
    const int fr = lane & 15, fq = lane >> 4;
    const unsigned lds0 = (unsigned)(uintptr_t)ring;
    const int prow = lane >> 3;
    const int kq = (lane & 7) ^ ((4 * (wid & 1) + (lane >> 4)) & 7);
    const int vq = (lane & 7) ^ (((prow >> 1) & 3) << 1);
    const unsigned koff = (unsigned)((8 * wid + prow) * kv_pitch + kq * 8) * 2u, voff = (unsigned)((8 * wid + prow) * kv_pitch + vq * 8) * 2u;
#define A16_DMA_K(t, slot) do { const bf16_t* ks_ = Kh + (size_t)(t) * 64 * kv_pitch; const unsigned kd_ = (unsigned)__builtin_amdgcn_readfirstlane(lds0 + (slot) * SLOTB + K_OFF + wid * 4096); \
        _Pragma("unroll") for (int j_ = 0; j_ < 4; ++j_) glds16s(koff, ks_ + j_ * 64, kd_ + j_ * 1024); } while (0)
#define A16_DMA_V(t, slot) do { const bf16_t* vs_ = Vh + (size_t)(t) * 64 * kv_pitch; const unsigned vd_ = (unsigned)__builtin_amdgcn_readfirstlane(lds0 + (slot) * SLOTB + V_OFF + wid * 4096); \
        _Pragma("unroll") for (int j_ = 0; j_ < 4; ++j_) glds16s(voff, vs_ + j_ * 64, vd_ + j_ * 1024); } while (0)
#define A16_DMA_K1(t, slot, j) glds16s_nc(koff, Kh + (size_t)(t) * 64 * kv_pitch + (j) * 64, (unsigned)__builtin_amdgcn_readfirstlane(lds0 + (slot) * SLOTB + K_OFF + wid * 4096 + (j) * 1024))
#define A16_DMA_V1(t, slot, j) glds16s_nc(voff, Vh + (size_t)(t) * 64 * kv_pitch + (j) * 64, (unsigned)__builtin_amdgcn_readfirstlane(lds0 + (slot) * SLOTB + V_OFF + wid * 4096 + (j) * 1024))
    A16_DMA_K(0, 0); A16_DMA_V(0, 0);
    if (NT > 1) A16_DMA_K(1, 1);
    bf16x8 qr[2][4];
    const bf16_t* qp = Qw + (size_t)fr * q_pitch + fq * 8;
#pragma unroll
    for (int qh = 0; qh < 2; ++qh)
#pragma unroll
        for (int d = 0; d < 4; ++d) qr[qh][d] = *(const bf16x8*)(qp + (size_t)(qh * 16) * q_pitch + d * 32);
    const f32x4 z4 = {0.f, 0.f, 0.f, 0.f};
#pragma unroll
    for (int db = 0; db < 16; ++db) { O[db][0] = z4; O[db][1] = z4; }
    float l0 = 0.f, l1 = 0.f;
    const int ksw = (fr >> 1) & 7;
    const LAS unsigned char* kb0 = ring + K_OFF + (kch0 >> 3) * 1024 + (fr >> 3) * 4096 + (fr & 7) * 128;
    const LAS unsigned char* kbp[2] = {kb0 + ((0 + fq) ^ ksw) * 16, kb0 + ((4 + fq) ^ ksw) * 16};
    const int vsw = ((2 * (fq & 1) + (fr >> 3)) & 3) << 1;
    const LAS unsigned char* vb0 = ring + V_OFF + (fq >> 1) * 4096 + (4 * (fq & 1) + (fr >> 2)) * 128 + ((fr & 3) >> 1) * 16 + (fr & 1) * 8;
    const LAS unsigned char* vbp[4] = {vb0 + ((0 ^ vsw) << 4), vb0 + ((2 ^ vsw) << 4), vb0 + ((4 ^ vsw) << 4), vb0 + ((6 ^ vsw) << 4)};
    f32x4 S[4][2]; u32x4 pw[2][2];
    f32x4 nb4 = {negb, negb, negb, negb}; asm volatile("" : "+v"(nb4));
#define A16_KF(kb, ds) (*(const LAS bf16x8*)(kbp[(ds) & 1] + so_ + (kb) * 8192 + ((ds) >> 1) * 1024))
#define A16_QK(tt, DMAI, td) do { const int so_ = ((tt) & 1) * SLOTB; const int tk_ = ((td) + 2 < NT) ? (td) + 2 : NT - 1, tv_ = ((td) + 1 < NT) ? (td) + 1 : NT - 1; (void)tk_; (void)tv_; \
        bf16x8 kf_[3]; kf_[0] = A16_KF(0, 0); kf_[1] = A16_KF(1, 0); \
        ATT_SB(); \
        _Pragma("unroll") for (int g_ = 0; g_ < 16; ++g_) { const int ds_ = g_ >> 2, kb_ = g_ & 3; \
            if (g_ + 2 < 16) kf_[(g_ + 2) % 3] = A16_KF((g_ + 2) & 3, (g_ + 2) >> 2); \
            S[kb_][0] = __builtin_amdgcn_mfma_f32_16x16x32_bf16(kf_[g_ % 3], qr[0][ds_], (ds_ == 0) ? nb4 : S[kb_][0], 0, 0, 0); \
            S[kb_][1] = __builtin_amdgcn_mfma_f32_16x16x32_bf16(kf_[g_ % 3], qr[1][ds_], (ds_ == 0) ? nb4 : S[kb_][1], 0, 0, 0); \
            if ((DMAI) && g_ < 8) { if (g_ < 4) A16_DMA_K1(tk_, (td) & 1, g_); else A16_DMA_V1(tv_, ((td) + 1) & 1, g_ - 4); } \
            ATT_SB(); } } while (0)
#define A16_EL(i) S[(i) >> 3][((i) >> 2) & 1][(i) & 3]
#define A16_PACK() do { _Pragma("unroll") for (int p_ = 0; p_ < 2; ++p_) _Pragma("unroll") for (int h_ = 0; h_ < 2; ++h_) \
        pw[p_][h_] = (u32x4){pk2(S[2 * p_][h_][0], S[2 * p_][h_][1]), pk2(S[2 * p_][h_][2], S[2 * p_][h_][3]), pk2(S[2 * p_ + 1][h_][0], S[2 * p_ + 1][h_][1]), pk2(S[2 * p_ + 1][h_][2], S[2 * p_ + 1][h_][3])}; } while (0)
    ATT_WAIT_BAR();
#pragma unroll
    for (int qh = 0; qh < 2; ++qh)
#pragma unroll
        for (int d = 0; d < 4; ++d) asm volatile("" : "+v"(qr[qh][d]));
    {
        A16_QK(0, 0, 0);
        float s0 = 0.f, s1 = 0.f;
#pragma unroll
        for (int i = 0; i < 32; ++i) { A16_EL(i) = __builtin_amdgcn_exp2f(A16_EL(i)); if ((i >> 2) & 1) s1 += A16_EL(i); else s0 += A16_EL(i); }
        l0 += s0; l1 += s1;
        A16_PACK();
    }
#pragma unroll 1
    for (int t = 0; t < NT; ++t) {
        ATT_WAIT_BAR();
        if (t < nt_act) {
            const bool more = (t + 1 < nt_act);
            const int vso = (t & 1) * SLOTB;
            s16x4 vv[3][2];
#define A16_VLD(v, g) do { const LAS unsigned char* a_ = vbp[(g) & 3] + vso + ((g) >> 4) * 16384 + (((g) & 15) >> 2) * 1024; v[0] = vtr(a_); v[1] = vtr(a_ + 8192); } while (0)
#define A16_VF(v) (bf16x8){v[0][0], v[0][1], v[0][2], v[0][3], v[1][0], v[1][1], v[1][2], v[1][3]}
            A16_VLD(vv[0], 0);
            ATT_SB();
            A16_QK(t + 1, 1, t);
            ATT_SB();
            A16_VLD(vv[1], 1);
            float s0 = 0.f, s1 = 0.f;
#define A16_GAP(i) do { A16_EL(i) = __builtin_amdgcn_exp2f(A16_EL(i)); \
                if ((i) > 0) { if ((((i) - 1) >> 2) & 1) s1 += A16_EL((i) - 1); else s0 += A16_EL((i) - 1); } asm volatile("" : "+v"(s0), "+v"(s1)); } while (0)
#pragma unroll
            for (int g = 0; g < 32; ++g) {
                if (g + 2 < 32) A16_VLD(vv[(g + 2) % 3], g + 2);
                ATT_SB();
                O[g & 15][0] = __builtin_amdgcn_mfma_f32_16x16x32_bf16(A16_VF(vv[g % 3]), __builtin_bit_cast(bf16x8, pw[g >> 4][0]), O[g & 15][0], 0, 0, 0);
                O[g & 15][1] = __builtin_amdgcn_mfma_f32_16x16x32_bf16(A16_VF(vv[g % 3]), __builtin_bit_cast(bf16x8, pw[g >> 4][1]), O[g & 15][1], 0, 0, 0);
                A16_GAP(g);
                ATT_SB();
            }
#undef A16_VLD
#undef A16_VF
#undef A16_GAP
            l0 += more ? s0 : 0.f; l1 += more ? (s1 + A16_EL(31)) : 0.f;
            A16_PACK();
        }
    }
    ATT_WAIT_BAR();
    l0 += sx<16>(l0); l1 += sx<16>(l1);
    lq[0] = sum32x(l0); lq[1] = sum32x(l1);
#undef A16_DMA_K
#undef A16_DMA_V
#undef A16_DMA_K1
#undef A16_DMA_V1
#undef A16_QK
#undef A16_KF
#undef A16_EL
#undef A16_PACK
}

__device__ __forceinline__ void mem_attn_core16(const bf16_t* Qw, int q_pitch, const bf16_t* Kh, const bf16_t* Vh, int kv_pitch, float negb, LAS unsigned char* ring, int wid, bf16_t* Yw, int y_pitch) {
    int lane = (int)__builtin_amdgcn_mbcnt_hi(~0u, __builtin_amdgcn_mbcnt_lo(~0u, 0u)); asm volatile("" : "+v"(lane));
    const int fr = lane & 15, fq = lane >> 4;
    const unsigned lds0 = (unsigned)(uintptr_t)ring;
    const int prow = lane >> 3;
    const int kq = (lane & 7) ^ ((4 * (wid & 1) + (lane >> 4)) & 7);
    const int vq = (lane & 7) ^ (((prow >> 1) & 3) << 1);
    const unsigned koff = (unsigned)((8 * wid + prow) * kv_pitch + kq * 8) * 2u, voff = (unsigned)((8 * wid + prow) * kv_pitch + vq * 8) * 2u;
    const unsigned dst0 = (unsigned)__builtin_amdgcn_readfirstlane(lds0 + wid * 4096);
#pragma unroll
    for (int t = 0; t < 4; ++t)
#pragma unroll
        for (int j = 0; j < 4; ++j) glds16s(koff, Kh + (size_t)t * 64 * kv_pitch + j * 64, dst0 + t * 32768 + j * 1024);
    const bf16_t* qp = Qw + (size_t)fr * q_pitch + fq * 8;
    const int ksw = (fr >> 1) & 7;
    const LAS unsigned char* kb0 = ring + (fr >> 3) * 4096 + (fr & 7) * 128;
    const LAS unsigned char* kbp[2] = {kb0 + ((0 + fq) ^ ksw) * 16, kb0 + ((4 + fq) ^ ksw) * 16};
    asm volatile("s_waitcnt vmcnt(0) lgkmcnt(0)\n\ts_barrier" ::: "memory");
    f32x4 S[4][4][2];
    const f32x4 z4 = {0.f, 0.f, 0.f, 0.f};
#pragma unroll
    for (int hf = 0; hf < 2; ++hf) {
        bf16x8 qr[2][4];
#pragma unroll
        for (int qh = 0; qh < 2; ++qh)
#pragma unroll
            for (int d = 0; d < 4; ++d) qr[qh][d] = *(const bf16x8*)(qp + (size_t)(qh * 16) * q_pitch + (hf * 4 + d) * 32);
#pragma unroll
        for (int t = 0; t < 4; ++t)
#pragma unroll
            for (int kb = 0; kb < 4; ++kb)
#pragma unroll
                for (int d = 0; d < 4; ++d) { const int ds = hf * 4 + d;
                    const bf16x8 kf = *(const LAS bf16x8*)(kbp[ds & 1] + t * 32768 + kb * 8192 + (ds >> 1) * 1024);
#pragma unroll
                    for (int qh = 0; qh < 2; ++qh) S[t][kb][qh] = __builtin_amdgcn_mfma_f32_16x16x32_bf16(kf, qr[qh][d], (ds == 0) ? z4 : S[t][kb][qh], 0, 0, 0);
                    if (d & 1) __builtin_amdgcn_sched_barrier(0); }
    }
    asm volatile("s_waitcnt lgkmcnt(0)\n\ts_barrier" ::: "memory");
#pragma unroll
    for (int t = 0; t < 4; ++t)
#pragma unroll
        for (int j = 0; j < 4; ++j) glds16s(voff, Vh + (size_t)t * 64 * kv_pitch + j * 64, dst0 + t * 32768 + j * 1024);
    float l[2] = {0.f, 0.f}; u32x4 pw[4][2][2];
#pragma unroll
    for (int t = 0; t < 4; ++t)
#pragma unroll
        for (int p = 0; p < 2; ++p)
#pragma unroll
            for (int qh = 0; qh < 2; ++qh) { f32x4 a = S[t][2 * p][qh], b = S[t][2 * p + 1][qh];
#pragma unroll
                for (int e = 0; e < 4; ++e) { a[e] = __builtin_amdgcn_exp2f(a[e] + negb); b[e] = __builtin_amdgcn_exp2f(b[e] + negb); }
                l[qh] += ((a[0] + a[1]) + (a[2] + a[3])) + ((b[0] + b[1]) + (b[2] + b[3])); asm volatile("" : "+v"(l[qh]));
                pw[t][p][qh] = (u32x4){pk2(a[0], a[1]), pk2(a[2], a[3]), pk2(b[0], b[1]), pk2(b[2], b[3])};
                __builtin_amdgcn_sched_barrier(0); }
    const int vsw = ((2 * (fq & 1) + (fr >> 3)) & 3) << 1;
    const LAS unsigned char* vb0 = ring + (fq >> 1) * 4096 + (4 * (fq & 1) + (fr >> 2)) * 128 + ((fr & 3) >> 1) * 16 + (fr & 1) * 8;
    const LAS unsigned char* vbp[4] = {vb0 + ((0 ^ vsw) << 4), vb0 + ((2 ^ vsw) << 4), vb0 + ((4 ^ vsw) << 4), vb0 + ((6 ^ vsw) << 4)};
    asm volatile("s_waitcnt vmcnt(0) lgkmcnt(0)\n\ts_barrier" ::: "memory");
    f32x4 O[16][2];
#pragma unroll
    for (int t = 0; t < 4; ++t)
#pragma unroll
        for (int p = 0; p < 2; ++p)
#pragma unroll
            for (int db = 0; db < 16; ++db) {
                const LAS unsigned char* va = vbp[db & 3] + t * 32768 + p * 16384 + (db >> 2) * 1024;
                const s16x4 lo = vtr(va), hh = vtr(va + 8192);
                const bf16x8 vf = (bf16x8){lo[0], lo[1], lo[2], lo[3], hh[0], hh[1], hh[2], hh[3]};
#pragma unroll
                for (int qh = 0; qh < 2; ++qh) O[db][qh] = __builtin_amdgcn_mfma_f32_16x16x32_bf16(vf, __builtin_bit_cast(bf16x8, pw[t][p][qh]), (t == 0 && p == 0) ? z4 : O[db][qh], 0, 0, 0);
                if (db & 1) __builtin_amdgcn_sched_barrier(0); }
    asm volatile("s_waitcnt lgkmcnt(0)\n\ts_barrier" ::: "memory");
    LAS unsigned char* rb = ring + wid * 16384;
#pragma unroll
    for (int qh = 0; qh < 2; ++qh) { float ls = l[qh]; ls += sx<16>(ls); ls = sum32x(ls);
        const float inv = __builtin_amdgcn_rcpf(ls);
#pragma unroll
        for (int db = 0; db < 16; ++db) { const f32x4 v = O[db][qh] * inv; u32x2 w; w.x = pk2(v[0], v[1]); w.y = pk2(v[2], v[3]); rowbuf_put(rb, fr, fq, qh, db, w); } }
    rowbuf_store<32>(rb, lane, Yw, y_pitch);
}
}

#define XB_TMO      128
#define XB_XCNT(j)  (256  + 64 * (j))
#define XB_XSUB(j)  (1280 + 64 * (j))
#define XB_XGEN(j)  (2304 + 64 * (j))
#define XB_TOP      3328
#define XB_TOPGEN   3392
#define XCD_BAR_WORDS 3456
#define XB_SPIN_CAP (1u << 22)

__device__ __forceinline__ unsigned xb_ld(unsigned* p)              { return __hip_atomic_load(p, __ATOMIC_RELAXED, __HIP_MEMORY_SCOPE_AGENT); }
__device__ __forceinline__ unsigned xb_add(unsigned* p, unsigned v) { return __hip_atomic_fetch_add(p, v, __ATOMIC_RELAXED, __HIP_MEMORY_SCOPE_AGENT); }
__device__ __forceinline__ unsigned xb_xcc_id() { return (unsigned)__builtin_amdgcn_s_getreg((3 << 11) | 20) & 0xFu; }
#define XB_SPIN(cond, bar) do { unsigned _sp = 0; while (cond) { __builtin_amdgcn_s_sleep(1); \
    if ((++_sp & 255u) == 0u) { if (xb_ld(&(bar)[XB_TMO])) break; if (_sp > XB_SPIN_CAP) { atomicAdd(&(bar)[XB_TMO], 1u); break; } } } } while (0)

struct XcdBarrier { unsigned* bar; unsigned x; volatile LAS unsigned* st; };

__device__ __forceinline__ XcdBarrier xcd_barrier_post(unsigned* bar, volatile LAS unsigned* st) {
    XcdBarrier b; b.bar = bar; b.x = xb_xcc_id(); b.st = st;
    if (threadIdx.x == 0) (void)xb_add(&bar[XB_XCNT(b.x)], 1u);
    return b;
}
__device__ __forceinline__ bool xb_leader(int wave) { return wave == 0 && __builtin_amdgcn_mbcnt_hi(~0u, __builtin_amdgcn_mbcnt_lo(~0u, 0u)) == 0u; }
__device__ __forceinline__ void xcd_barrier_complete(unsigned* bar, unsigned x, unsigned& nloc, unsigned& nx) {
    const unsigned G = gridDim.x * gridDim.y * gridDim.z;
    unsigned sum, cnt, mine, sp = 0u;
    for (;;) {
        sum = 0u; cnt = 0u; mine = 0u;
#pragma unroll
        for (unsigned j = 0; j < 16; ++j) { const unsigned c = xb_ld(&bar[XB_XCNT(j)]); sum += c; cnt += (c > 0u) ? 1u : 0u; mine = (j == x) ? c : mine; }
        if (sum == G) break;
        __builtin_amdgcn_s_sleep(1);
        if ((++sp & 255u) == 0u) { if (xb_ld(&bar[XB_TMO])) break; if (sp > XB_SPIN_CAP) { atomicAdd(&bar[XB_TMO], 1u); break; } }
    }
    nloc = mine > 0u ? mine : 1u; nx = cnt > 0u ? cnt : 1u;
}
__device__ __forceinline__ void xcd_barrier(const XcdBarrier& b, const int wave) {
    asm volatile("s_waitcnt vmcnt(0)" ::: "memory");
    __syncthreads();
    if (xb_leader(wave)) {
        unsigned* bar = b.bar;
        __builtin_amdgcn_s_waitcnt(0);
        unsigned nloc = b.st[0], nx = b.st[1];
        if (nloc == 0u) { xcd_barrier_complete(bar, b.x, nloc, nx); b.st[0] = nloc; b.st[1] = nx; }
        const unsigned old = xb_add(&bar[XB_XSUB(b.x)], 1u);
        const unsigned gen = old / nloc;
        if (old + 1u == (gen + 1u) * nloc) {
            __builtin_amdgcn_fence(__ATOMIC_RELEASE, "agent");
            asm volatile("s_waitcnt vmcnt(0)" ::: "memory");
            const unsigned og = xb_add(&bar[XB_TOP], 1u);
            const unsigned tg = og / nx;
            if (og + 1u == (tg + 1u) * nx) xb_add(&bar[XB_TOPGEN], 1u);
            else XB_SPIN(xb_ld(&bar[XB_TOPGEN]) == tg, bar);
            __builtin_amdgcn_fence(__ATOMIC_ACQUIRE, "agent");
            xb_add(&bar[XB_XGEN(b.x)], 1u);
            asm volatile("s_waitcnt vmcnt(0)" ::: "memory");
        } else {
            XB_SPIN(xb_ld(&bar[XB_XGEN(b.x)]) == gen, bar);
            __builtin_amdgcn_fence(__ATOMIC_ACQUIRE, "agent");
            asm volatile("s_waitcnt vmcnt(0)" ::: "memory");
        }
    }
    __syncthreads();
}

__device__ __forceinline__ void transpose_item(const float* W, int N, int k0, int nsrc0, bf16_t* WT, int ldt, int ndst0, LAS float* scr, int lane, const float* kscale = nullptr) {
    float wv[32];
#pragma unroll
    for (int i = 0; i < 32; ++i) wv[i] = __builtin_nontemporal_load(&W[(size_t)(k0 + 2 * i + (lane >> 5)) * N + nsrc0 + (lane & 31)]);
#pragma unroll
    for (int i = 0; i < 32; ++i) { const int kk = 2 * i + (lane >> 5); const float sc = kscale ? kscale[k0 + kk] : 1.0f; scr[kk * 33 + (lane & 31)] = wv[i] * sc; }
    LDS_WAIT(); asm volatile("" ::: "memory");
    const int c = lane & 7;
#pragma unroll
    for (int j = 0; j < 4; ++j) { const int n = (lane >> 3) + 8 * j; const LAS float* s = scr + (8 * c) * 33 + n;
        u32x4 o; o.x = pk2(s[0 * 33], s[1 * 33]); o.y = pk2(s[2 * 33], s[3 * 33]); o.z = pk2(s[4 * 33], s[5 * 33]); o.w = pk2(s[6 * 33], s[7 * 33]);
        *(GAS u32x4*)(WT + (size_t)(ndst0 + n) * ldt + k0 + 8 * c) = o; }
    LDS_WAIT(); asm volatile("" ::: "memory");
}
__device__ __forceinline__ void transpose_item_fp8(const float* W, int N, int k0, int nsrc0, unsigned char* WT8, int ldt, int ndst0, LAS float* scr, int lane, float scale) {
    float wv[32];
#pragma unroll
    for (int i = 0; i < 32; ++i) wv[i] = __builtin_nontemporal_load(&W[(size_t)(k0 + 2 * i + (lane >> 5)) * N + nsrc0 + (lane & 31)]);
#pragma unroll
    for (int i = 0; i < 32; ++i) { const int kk = 2 * i + (lane >> 5); scr[kk * 33 + (lane & 31)] = wv[i] * scale; }
    LDS_WAIT(); asm volatile("" ::: "memory");
    const int c = lane & 7;
#pragma unroll
    for (int j = 0; j < 4; ++j) { const int n = (lane >> 3) + 8 * j; const LAS float* s = scr + (8 * c) * 33 + n;
        u32x2 o; o.x = pk4_fp8(s[0 * 33], s[1 * 33], s[2 * 33], s[3 * 33]); o.y = pk4_fp8(s[4 * 33], s[5 * 33], s[6 * 33], s[7 * 33]);
        *(GAS u32x2*)(WT8 + (size_t)(ndst0 + n) * ldt + k0 + 8 * c) = o; }
    LDS_WAIT(); asm volatile("" ::: "memory");
}
__device__ __forceinline__ void ti_load(float (&wv)[32], const float* W, int N, int k0, int nsrc0, int lane) {
#pragma unroll
    for (int i = 0; i < 32; ++i) wv[i] = __builtin_nontemporal_load(&W[(size_t)(k0 + 2 * i + (lane >> 5)) * N + nsrc0 + (lane & 31)]);
}
__device__ __forceinline__ void ti_finish(const float (&wv)[32], int k0, bf16_t* WT, int ldt, int ndst0, LAS float* scr, int lane, const float* kscale) {
#pragma unroll
    for (int i = 0; i < 32; ++i) { const int kk = 2 * i + (lane >> 5); scr[kk * 33 + (lane & 31)] = wv[i] * kscale[k0 + kk]; }
    LDS_WAIT(); asm volatile("" ::: "memory");
    const int c = lane & 7;
#pragma unroll
    for (int j = 0; j < 4; ++j) { const int n = (lane >> 3) + 8 * j; const LAS float* sp = scr + (8 * c) * 33 + n;
        u32x4 o; o.x = pk2(sp[0 * 33], sp[1 * 33]); o.y = pk2(sp[2 * 33], sp[3 * 33]); o.z = pk2(sp[4 * 33], sp[5 * 33]); o.w = pk2(sp[6 * 33], sp[7 * 33]);
        *(GAS u32x4*)(WT + (size_t)(ndst0 + n) * ldt + k0 + 8 * c) = o; }
    LDS_WAIT(); asm volatile("" ::: "memory");
}
__constant__ unsigned char QB_TAB[15][5] = {
    {59, 34, 33, 5, 3}, {58, 38, 32, 4, 2}, {61, 35, 31, 6, 1}, {60, 37, 30, 7, 0}, {63, 36, 29, 8, 255}, {62, 39, 26, 9, 255}, {57, 40, 28, 10, 255}, {56, 41, 27, 11, 255},
    {55, 42, 25, 12, 255}, {54, 43, 24, 13, 255}, {53, 44, 23, 14, 255}, {52, 45, 22, 15, 255}, {51, 46, 21, 16, 255}, {50, 47, 20, 17, 255}, {49, 48, 19, 18, 255}};

__device__ __forceinline__ void tr_plain(const float* W, int K, int N, bf16_t* WT, LAS float* scr, int r, int lane) {
    const int nblk = N / 32, kb = r / nblk, nb = r % nblk;
    transpose_item(W, N, 64 * kb, 32 * nb, WT, K, 32 * nb, scr, lane);
}
__device__ __forceinline__ void rms_row_4096(const float* xrow, const float* g, bf16_t* orow, int lane, unsigned char* qrow = nullptr, float* rs_out = nullptr) {
    const GAS f32x4* xr = (const GAS f32x4*)xrow + lane; const GAS f32x4* gr = (const GAS f32x4*)g + lane;
    f32x4 v[16]; float s = 0.f;
#pragma unroll
    for (int j = 0; j < 16; ++j) { v[j] = __builtin_nontemporal_load(xr + 64 * j); s += (v[j].x * v[j].x + v[j].y * v[j].y) + (v[j].z * v[j].z + v[j].w * v[j].w); }
    const float rstd = 1.f / sqrtf(wave_sum(s) * (1.f / 4096.f) + EPS);
    if (rs_out != nullptr && lane == 0) *rs_out = rstd;
    GAS u32x2* o8 = (GAS u32x2*)orow + lane;
#pragma unroll
    for (int j = 0; j < 16; ++j) { const f32x4 gg = gr[64 * j]; const float y0 = v[j].x * rstd * gg.x, y1 = v[j].y * rstd * gg.y, y2 = v[j].z * rstd * gg.z, y3 = v[j].w * rstd * gg.w;
        u32x2 w; if (rs_out != nullptr) { w.x = pk2(v[j].x, v[j].y); w.y = pk2(v[j].z, v[j].w); } else { w.x = pk2(y0, y1); w.y = pk2(y2, y3); }
        o8[64 * j] = w;
        if (qrow) ((GAS unsigned*)qrow + lane)[64 * j] = pk4_fp8(y0, y1, y2, y3); }
}
__constant__ float ROPE_INV2PI[16] = {1.5915494309e-01f, 7.0086521588e-02f, 3.0863763405e-02f, 1.3591370636e-02f, 5.9851857127e-03f, 2.6356758987e-03f, 1.1606636412e-03f, 5.1111750454e-04f,
                                      2.2507907904e-04f, 9.9117309369e-05f, 4.3647952793e-05f, 1.9221100685e-05f, 8.4643308082e-06f, 3.7274086019e-06f, 1.6414262628e-06f, 7.2282930688e-07f};
template <int W>
__device__ __forceinline__ void pool_prep_seg(const bf16_t* src, bf16_t* dst, int t0) {
    u32x4 wv[W - 1 + 16];
#pragma unroll
    for (int k = 0; k < W - 1 + 16; ++k) { const int rel = k - (W - 1); wv[k] = (rel >= 0 || t0 > 0) ? *(const u32x4*)(src + (ptrdiff_t)rel * 1024) : (u32x4){0u, 0u, 0u, 0u}; }
    float sm[8];
#pragma unroll
    for (int e = 0; e < 8; ++e) sm[e] = 0.f;
#pragma unroll
    for (int k = 0; k < W - 1; ++k) { float f[8]; unpack8(wv[k], f);
#pragma unroll
        for (int e = 0; e < 8; ++e) sm[e] += f[e]; }
#pragma unroll
    for (int j = 0; j < 16; ++j) { float cur[8], f[8]; unpack8(wv[W - 1 + j], cur);
#pragma unroll
        for (int e = 0; e < 8; ++e) sm[e] += cur[e];
        const int n = (t0 > 0 || j + 1 >= W) ? W : j + 1; const float inv = 1.0f / (float)n;
        u32x4 o; o.x = pk2(sm[0] * inv - cur[0], sm[1] * inv - cur[1]); o.y = pk2(sm[2] * inv - cur[2], sm[3] * inv - cur[3]);
        o.z = pk2(sm[4] * inv - cur[4], sm[5] * inv - cur[5]); o.w = pk2(sm[6] * inv - cur[6], sm[7] * inv - cur[7]);
        *(u32x4*)(dst + (size_t)j * 1024) = o;
        unpack8(wv[j], f);
#pragma unroll
        for (int e = 0; e < 8; ++e) sm[e] -= f[e]; }
}

struct Args { const float* in[26]; float* out; unsigned char* ws; };

__global__ void __launch_bounds__(NWAVES * 64, 2) mk_fwd(Args args) {
    extern __shared__ __attribute__((aligned(16))) unsigned char lds_raw[];
    LAS unsigned char* lds = (LAS unsigned char*)lds_raw;
    volatile LAS unsigned* MISC = (volatile LAS unsigned*)(lds + MISC_OFF);
    const int wave = __builtin_amdgcn_readfirstlane(threadIdx.x >> 6);
#define PHASE_IDS() int lane = (int)__builtin_amdgcn_mbcnt_hi(~0u, __builtin_amdgcn_mbcnt_lo(~0u, 0u)); asm volatile("" : "+v"(lane)); const int tid = wave * 64 + lane; const int gw = vcu * NWAVES + wave, NGW = G * NWAVES; (void)tid; (void)gw; (void)NGW
    const int G = gridDim.x; const int bx = blockIdx.x; const int vcu = (G % 8 == 0) ? (bx % 8) * (G / 8) + bx / 8 : bx;
    unsigned char* ws = args.ws;
    unsigned* ctl = (unsigned*)(ws + WS_CTL);
    const float* x = args.in[0]; const float* mem = args.in[1]; const float* g_attn = args.in[2]; const float* w_in = args.in[3];
    const float* g_qa = args.in[4]; const float* g_ka = args.in[5]; const float* lam_q1 = args.in[6]; const float* lam_k1 = args.in[7];
    const float* lam_q2 = args.in[8]; const float* lam_k2 = args.in[9]; const float* g_subln = args.in[10]; const float* w_pool = args.in[11];
    const float* pool_scale = args.in[12]; const float* g_mem = args.in[13]; const float* w_mkv = args.in[14]; const float* g_qm = args.in[15];
    const float* g_km = args.in[16]; const float* w_a = args.in[17]; const float* w_b = args.in[18]; const float* w_c = args.in[19];
    const float* w_o = args.in[20]; const float* g_ffn = args.in[21]; const float* w_up = args.in[22]; const float* conv_w = args.in[23];
    const float* conv_b = args.in[24]; const float* w_down = args.in[25];
    float* out = args.out;
    unsigned char* WG8 = ws + WS_WG8; unsigned char* H8 = (unsigned char*)out + DO_H8;
    bf16_t* W_UP = (bf16_t*)(ws + WS_WUP); bf16_t* W_DOWN = (bf16_t*)(ws + WS_WDOWN); bf16_t* W_IN = (bf16_t*)(ws + WS_WIN);
    bf16_t* W_A = (bf16_t*)(ws + WS_WA); bf16_t* W_B = (bf16_t*)(ws + WS_WB); bf16_t* W_C = (bf16_t*)(ws + WS_WC); bf16_t* W_O = (bf16_t*)(ws + WS_WO);
    bf16_t* W_MKV = (bf16_t*)(ws + WS_WMKV);
    bf16_t* KVM = (bf16_t*)(ws + WS_KVM); bf16_t* HM = (bf16_t*)(ws + WS_HM);
    bf16_t* QA = (bf16_t*)(ws + WS_QA); bf16_t* KA = (bf16_t*)(ws + WS_KA); bf16_t* VA = (bf16_t*)(ws + WS_VA);
    bf16_t* UPB = (bf16_t*)(ws + WS_UP); bf16_t* QM = (bf16_t*)(ws + WS_QM); unsigned char* GL = ws + WS_GL; bf16_t* YP = (bf16_t*)(ws + WS_YP);
    bf16_t* MERGED = (bf16_t*)(ws + WS_MERGED); bf16_t* X1B = (bf16_t*)(ws + WS_X1B); bf16_t* ACT = (bf16_t*)(ws + WS_ACT); float* SSQ = (float*)(ws + WS_SSQ); float* HALO = (float*)(ws + WS_HALO);
    bf16_t* XB = (bf16_t*)out; float* RS1 = (float*)(ws + WS_RS1); bf16_t* YA = (bf16_t*)((unsigned char*)out + DO_YA); bf16_t* YC = (bf16_t*)((unsigned char*)out + DO_YC);

    for (int u = threadIdx.x; u < (LDS_BYTES - LDSCTL_OFF) / 4; u += NWAVES * 64) ((LAS unsigned*)(lds + LDSCTL_OFF))[u] = 0u;
    __syncthreads();
    XcdBarrier bar = xcd_barrier_post(ctl + CW_BAR, MISC + 8);

    {
        PHASE_IDS();
        LAS float* scr = (LAS float*)(lds + RING_OFF + wave * 16384);
        for (int it = gw; it < 64 * 64; it += NGW) tr_plain(w_mkv, 4096, 2048, W_MKV, scr, it, lane);
        for (int m = gw; m < MROWS; m += NGW) rms_row_4096(mem + (size_t)m * DMODEL, g_mem, HM + (size_t)m * DMODEL, lane);
    }
    constexpr int MKV_CUS = 16;
    const bool p0_split = (G > 2 * MKV_CUS);
    if (p0_split) {
        asm volatile("s_waitcnt vmcnt(0)" ::: "memory");
        __syncthreads();
        if (xb_leader(wave)) { __builtin_amdgcn_fence(__ATOMIC_RELEASE, "agent"); asm volatile("s_waitcnt vmcnt(0)" ::: "memory"); (void)xb_add(ctl + CW_P0A, 1u); }
    } else xcd_barrier(bar, wave);
    if (vcu < MKV_CUS && p0_split) {
        if (xb_leader(wave)) { XB_SPIN(xb_ld(ctl + CW_P0A) != (unsigned)G, ctl + CW_BAR); __builtin_amdgcn_fence(__ATOMIC_ACQUIRE, "agent"); asm volatile("s_waitcnt vmcnt(0)" ::: "memory"); }
        __syncthreads();
        struct OneUnit { int id; __device__ __forceinline__ bool next(int i, pg8::Unit& u) const { if (i != 0) return false; u.pm = id >> 3; u.pn = id & 7; return true; } };
        pg8::Gemm1 g{HM, W_MKV, DMODEL, DMODEL, DMODEL, 0}; OneUnit S{vcu};
        pg8::EpiKvm E{KVM, g_km, (LAS float*)(lds + XCH_OFF)};
        pg8::gemm_phase<pg8::EpiKvm, OneUnit, pg8::Gemm1>(lds + RING_OFF, g, S, E, wave);
        {
            PHASE_IDS();
            LAS float* scr = (LAS float*)(lds + RING_OFF + wave * 16384);
            for (int it = wave; it < 128; it += NWAVES) { const int kb = it >> 3, nb = it & 7;
                transpose_item(w_b, 4096, 64 * kb, 256 * vcu + 32 * nb, W_B, 1024, 256 * vcu + 32 * nb, scr, lane, pool_scale); }
            bf16_t* WPc = (bf16_t*)(ws + WS_WPF) + (size_t)vcu * (1024 * 256);
#pragma unroll 1
            for (int r0 = wave * 128; r0 < wave * 128 + 128; r0 += 16) { f32x4 v[16];
#pragma unroll
                for (int j = 0; j < 16; ++j) v[j] = __builtin_nontemporal_load((const f32x4*)(w_pool + (size_t)(r0 + j) * 256 + 4 * lane));
#pragma unroll
                for (int j = 0; j < 16; ++j) { u32x2 w; w.x = pk2(v[j][0], v[j][1]); w.y = pk2(v[j][2], v[j][3]); *(u32x2*)(WPc + (size_t)(r0 + j) * 256 + 4 * lane) = w; } }
            asm volatile("s_waitcnt vmcnt(0)" ::: "memory");
            __syncthreads();
            if (xb_leader(wave)) { __builtin_amdgcn_fence(__ATOMIC_ACQ_REL, "agent"); asm volatile("s_waitcnt vmcnt(0)" ::: "memory"); }
            __syncthreads();
            struct FoldUnits { int pm; __device__ __forceinline__ bool next(int i, pg8::Unit& u) const { if (i >= 4) return false; u.pm = pm; u.pn = i; return true; } };
            pg8::Gemm1 gf{W_B, WPc, 1024, 256, 256, 256}; FoldUnits Sf{vcu};
            pg8::EpiBf16 Ef{(bf16_t*)(ws + WS_WBF), 1024, nullptr};
            pg8::gemm_phase<pg8::EpiBf16, FoldUnits, pg8::Gemm1>(lds + RING_OFF, gf, Sf, Ef, wave);
        }
    } else {
        PHASE_IDS();
        const bool split = p0_split;
        const bool defer_wup = (G == 256);
        const bool defer_wdown = (G == 256);
        const int gwb = split ? (vcu - MKV_CUS) * NWAVES + wave : gw, NGWB = split ? (G - MKV_CUS) * NWAVES : NGW;
        LAS float* scr = (LAS float*)(lds + RING_OFF + wave * 16384);
        constexpr int I_IN = 64 * 640, I_A = 32 * 128, I_B = 0, I_C = 16 * 128, I_O = 64 * 128, I_UP = 64 * 688, I_DN = 172 * 128, I_PL = 0;
        constexpr int NITEMS = I_IN + I_A + I_B + I_C + I_O + I_UP + I_DN + I_PL;
        for (int it = gwb; it < NITEMS; it += NGWB) {
            int r = it;
            if (r < I_IN) { const int kb = r / 640, nb = r % 640;
                if (nb < 224) transpose_item(w_in, NIN, 64 * kb, 32 * nb, W_IN, 4096, 32 * nb, scr, lane, g_attn);
                else transpose_item_fp8(w_in, NIN, 64 * kb, 32 * nb, WG8, 4096, 32 * nb - 7168, scr, lane, 64.0f);
                continue; }
            r -= I_IN;
            if (r < I_A) { tr_plain(w_a, 2048, 4096, W_A, scr, r, lane); continue; }
            r -= I_A;
            if (r < I_B) { continue; }
            r -= I_B;
            if (r < I_C) { tr_plain(w_c, 1024, 4096, W_C, scr, r, lane); continue; }
            r -= I_C;
            if (r < I_O) { tr_plain(w_o, 4096, 4096, W_O, scr, r, lane); continue; }
            r -= I_O;
            if (r < I_UP) {
                const int kb = r / 688, nb = r % 688, nd = 32 * nb, tile = nd >> 8, j = nd & 255;
                const int nsrc = (j < 128) ? tile * 128 + j : DFF + tile * 128 + (j - 128);
                if (!defer_wup) transpose_item(w_up, NUP, 64 * kb, nsrc, W_UP, 4096, nd, scr, lane, g_ffn);
                continue; }
            r -= I_UP;
            if (r < I_DN) { if (!defer_wdown) tr_plain(w_down, DFF, 4096, W_DOWN, scr, r, lane); continue; }
            r -= I_DN;
            (void)r;
        }
        for (int m = gwb; m < MTOK; m += NGWB) rms_row_4096(x + (size_t)m * DMODEL, g_attn, XB + (size_t)m * DMODEL, lane, H8 + (size_t)m * DMODEL, RS1 + m);
    }
    xcd_barrier(bar, wave);

    {
        pg8::Gemm8 g{H8, WG8, DMODEL}; pg8::StaticOrder S; S.init(MTOK, 13312, G, bx);
        pg8::EpiG8 E{GL, QM, g_qm, (LAS float*)(lds + XCH_OFF)};
        pg8::gemm_phase<pg8::EpiG8, pg8::StaticOrder, pg8::Gemm8>(lds + RING_OFF, g, S, E, wave);
    }
    {
        pg8::Gemm1 g{XB, W_IN, DMODEL, DMODEL, DMODEL, 0}; pg8::StaticOrder S; S.init(MTOK, 7168, G, bx);
        pg8::Unit u0; int pm_base = 0;
        if (S.next(0, u0)) pm_base = u0.pm & ~7;
        { PHASE_IDS();
          LAS float* tab = (LAS float*)(lds + RSTD_OFF);
#pragma unroll
          for (int k = 0; k < 4; ++k) tab[tid + 512 * k] = RS1[pm_base * 256 + tid + 512 * k];
          asm volatile("s_waitcnt lgkmcnt(0)\n\ts_barrier" ::: "memory"); }
        pg8::EpiProj E{QA, UPB, QM, nullptr, (const LAS float*)(lds + RSTD_OFF), pm_base, g_qa, g_ka, g_qm, (LAS float*)(lds + XCH_OFF), ROPE_INV2PI};
        pg8::gemm_phase<pg8::EpiProj, pg8::StaticOrder, pg8::Gemm1>(lds + RING_OFF, g, S, E, wave);
    }
    xcd_barrier(bar, wave);

    {
        PHASE_IDS();
        {
            pg8::StaticOrder S; S.init(MTOK, 1024, G, bx); pg8::Unit pu;
            for (int i = 0; S.next(i, pu); ++i) {
                const int gq = pu.pn, row0 = pu.pm * 256 + (tid >> 5) * 16, c = gq * 32 + (tid & 31);
                const bf16_t* src = UPB + (size_t)row0 * 1024 + c * 8; bf16_t* dst = YP + (size_t)row0 * 1024 + c * 8; const int t0 = row0 & (SEQ - 1);
                if (gq == 0) pool_prep_seg<2>(src, dst, t0); else if (gq == 1) pool_prep_seg<4>(src, dst, t0); else if (gq == 2) pool_prep_seg<8>(src, dst, t0); else pool_prep_seg<16>(src, dst, t0);
            }
        }
        float lam, negb_a;
        {
            const float a1 = lam_q1[lane] * lam_k1[lane] + lam_q1[lane + 64] * lam_k1[lane + 64];
            const float a2 = lam_q2[lane] * lam_k2[lane] + lam_q2[lane + 64] * lam_k2[lane + 64];
            lam = expf(wave_sum(a1)) - expf(wave_sum(a2)) + LAMBDA_INIT;
            const float gq = wave_max(fmaxf(fabsf(g_qa[lane]), fabsf(g_qa[lane + 64]))), gk = wave_max(fmaxf(fabsf(g_ka[lane]), fabsf(g_ka[lane + 64])));
            negb_a = -(11.313708498984761f * LOG2E * 1.02f) * gq * gk;
            lam = __uint_as_float(__builtin_amdgcn_readfirstlane(__float_as_uint(lam))); negb_a = __uint_as_float(__builtin_amdgcn_readfirstlane(__float_as_uint(negb_a)));
        }
        LAS float* wsf = (LAS float*)(lds + WSF_OFF) + wave * 64;
        if (G == 256 && (vcu & 31) >= 30) {
            PHASE_IDS();
            LAS float* scr = (LAS float*)(lds + RING_OFF + wave * 16384);
            constexpr int I_UPC = 64 * 688, NCW = 16 * NWAVES;
            const int cw = ((vcu >> 5) * 2 + (vcu & 31) - 30) * NWAVES + wave;
#define WUP_ARGS(it_) const int kb_ = (it_) / 688, nb_ = (it_) % 688, nd_ = 32 * nb_, tile_ = nd_ >> 8, j_ = nd_ & 255; const int nsrc_ = (j_ < 128) ? tile_ * 128 + j_ : DFF + tile_ * 128 + (j_ - 128)
            float wa[32], wb[32];
            { WUP_ARGS(cw); ti_load(wa, w_up, NUP, 64 * kb_, nsrc_, lane); }
#pragma unroll 1
            for (int it = cw; it < I_UPC; it += 2 * NCW) {
                const int it2 = it + NCW, it3 = it + 2 * NCW;
                if (it2 < I_UPC) { WUP_ARGS(it2); ti_load(wb, w_up, NUP, 64 * kb_, nsrc_, lane); }
                { WUP_ARGS(it); (void)nsrc_; ti_finish(wa, 64 * kb_, W_UP, 4096, nd_, scr, lane, g_ffn); }
                if (it3 < I_UPC) { WUP_ARGS(it3); ti_load(wa, w_up, NUP, 64 * kb_, nsrc_, lane); }
                if (it2 < I_UPC) { WUP_ARGS(it2); (void)nsrc_; ti_finish(wb, 64 * kb_, W_UP, 4096, nd_, scr, lane, g_ffn); }
            }
#undef WUP_ARGS
            asm volatile("s_waitcnt vmcnt(0) lgkmcnt(0)\n\ts_barrier" ::: "memory");
        }
        if (G == 256 && (vcu & 31) < 30) {
            const int xj = vcu & 31, bh = (vcu >> 5) * 2 + xj / 15, slot = xj % 15, b = bh >> 3, h = bh & 7;
            const int comp = wave >> 2, qg = (wave & 3) ^ (comp << 1);
#pragma unroll 1
            for (int ui = 0; ui < 5; ++ui) {
                const int qb = QB_TAB[slot][ui];
                if (qb == 255) break;
                const size_t rowbase = (size_t)b * SEQ; const int q0 = qb * 128 + qg * 32;
                f32x4 O[16][2]; float lq[2];
                att::attn_core16(O, lq, QA + (rowbase + q0) * 2048 + h * 256 + comp * 128, 2048, KA + rowbase * 2048 + h * 256, VA + rowbase * 2048 + h * 256, 2048,
                                 2 * qb + 2, 2 * qb + 1 + (qg >> 1), comp * 16, negb_a, lds + RING_OFF, wave);
                int ln = (int)__builtin_amdgcn_mbcnt_hi(~0u, __builtin_amdgcn_mbcnt_lo(~0u, 0u)); asm volatile("" : "+v"(ln));
                const int fr = ln & 15, fq = ln >> 4;
                LAS f32x4* stage = (LAS f32x4*)(lds + RING_OFF + qg * 32768) + ln;
                const float f0 = ((comp == 1) ? lam : 1.0f) * __builtin_amdgcn_rcpf(lq[0]), f1 = ((comp == 1) ? lam : 1.0f) * __builtin_amdgcn_rcpf(lq[1]);
#define DA_FIN(MINE) do { \
                    _Pragma("unroll") for (int db = 0; db < 16; ++db) stage[((1 - (MINE)) * 16 + db) * 64] = O[db][1 - (MINE)] * ((MINE) ? f0 : f1); \
                    asm volatile("s_waitcnt lgkmcnt(0)\n\ts_barrier" ::: "memory"); \
                    const float fm_ = (MINE) ? f1 : f0; float ss = 0.f; \
                    _Pragma("unroll") for (int db = 0; db < 16; ++db) { const f32x4 a_ = O[db][MINE] * fm_, b_ = stage[((MINE) * 16 + db) * 64]; const f32x4 v = (MINE) ? (b_ - a_) : (a_ - b_); O[db][MINE] = v; \
                        ss += (v[0] * v[0] + v[1] * v[1]) + (v[2] * v[2] + v[3] * v[3]); } \
                    ss += sx<16>(ss); ss = sum32x(ss); \
                    const float rn = (1.0f - LAMBDA_INIT) * __builtin_amdgcn_rsqf(ss * (1.f / 256.f) + EPS); \
                    const float* gp = g_subln + 4 * fq; asm volatile("" : "+v"(gp)); \
                    LAS unsigned char* rb_ = lds + RING_OFF + qg * 32768 + (MINE) * 16384;        \
                    _Pragma("unroll") for (int db = 0; db < 16; ++db) { const f32x4 g4 = *(const f32x4*)(gp + 16 * db); const f32x4 v = O[db][MINE] * rn * g4; \
                        u32x2 w; w.x = pk2(v[0], v[1]); w.y = pk2(v[2], v[3]); att::rowbuf_put(rb_, fr, fq, 0, db, w); } \
                    att::rowbuf_store<16>(rb_, ln, YA + (rowbase + q0 + (MINE) * 16) * 2048 + h * 256, 2048); } while (0)
                if (comp == 0) DA_FIN(0); else DA_FIN(1);
#undef DA_FIN
                asm volatile("s_waitcnt lgkmcnt(0)\n\ts_barrier" ::: "memory");
            }
        }
        if (G == 256) {
            PHASE_IDS();
            LAS float* wsf = (LAS float*)(lds + WSF_OFF) + wave * 64;
            const int bhm = vcu >> 5, qb = vcu & 31, b = bhm >> 2, hm = bhm & 3;
            const size_t rowbase = (size_t)b * SEQ; const int q0 = qb * 256 + wave * 32;
            float negb_m;
            { float m1 = 0.f, m2 = 0.f;
#pragma unroll
              for (int j = 0; j < 4; ++j) { m1 = fmaxf(m1, fabsf(g_qm[lane + 64 * j])); m2 = fmaxf(m2, fabsf(g_km[lane + 64 * j])); }
              negb_m = -(16.0f * LOG2E * 1.02f) * wave_max(m1) * wave_max(m2);
              negb_m = __uint_as_float(__builtin_amdgcn_readfirstlane(__float_as_uint(negb_m))); }
            att::mem_attn_core16(QM + (rowbase + q0) * 1024 + hm * 256, 1024, KVM + (size_t)b * MEMLEN * 2048 + hm * 256, KVM + (size_t)b * MEMLEN * 2048 + 1024 + hm * 256, 2048, negb_m, lds + RING_OFF, wave,
                                 YC + (rowbase + q0) * 1024 + hm * 256, 1024);
        }
    }
    xcd_barrier(bar, wave);

    {
        pg8::StaticOrder S; S.init(MTOK, DMODEL, G, bx);
        pg8::Gemm3 g{{YA, YP, YC}, {W_A, (const bf16_t*)(ws + WS_WBF), W_C}, {2048, 1024, 1024}};
        pg8::EpiMerge E{MERGED, GL};
        pg8::gemm_phase<pg8::EpiMerge, pg8::StaticOrder, pg8::Gemm3>(lds + RING_OFF, g, S, E, wave);
    }
    xcd_barrier(bar, wave);

    {
        pg8::Gemm1 g{MERGED, W_O, DMODEL, DMODEL, DMODEL, 0}; pg8::StaticOrder S; S.init(MTOK, DMODEL, G, bx);
        pg8::EpiX1 E{XB, X1B, SSQ};
        pg8::gemm_phase<pg8::EpiX1, pg8::StaticOrder, pg8::Gemm1>(lds + RING_OFF, g, S, E, wave);
    }
    xcd_barrier(bar, wave);

    {
        pg8::Gemm1 g{X1B, W_UP, DMODEL, DMODEL, DMODEL, 0}; pg8::StaticOrder S; S.init(MTOK, NUP, G, bx);
        pg8::Unit u0; int pm_base = 0;
        if (S.next(0, u0)) pm_base = u0.pm & ~7;
        {
            PHASE_IDS();
            LAS float* tab = (LAS float*)(lds + RSTD_OFF);
#pragma unroll 1
            for (int k = 0; k < 4; k += 2) {
                const int lr0 = tid + 512 * k, lr1 = lr0 + 512; const float* p0 = SSQ + (size_t)(pm_base * 256 + lr0) * 64; const float* p1 = p0 + (size_t)512 * 64;
                f32x4 v0[16], v1[16];
#pragma unroll
                for (int j = 0; j < 16; ++j) { v0[j] = *(const f32x4*)(p0 + 4 * j); v1[j] = *(const f32x4*)(p1 + 4 * j); }
                float q0 = 0.f, q1 = 0.f;
#pragma unroll
                for (int j = 0; j < 16; ++j) { q0 += (v0[j][0] + v0[j][1]) + (v0[j][2] + v0[j][3]); q1 += (v1[j][0] + v1[j][1]) + (v1[j][2] + v1[j][3]); }
                tab[lr0] = 1.0f / sqrtf(q0 * (1.f / 4096.f) + EPS); tab[lr1] = 1.0f / sqrtf(q1 * (1.f / 4096.f) + EPS); }
            asm volatile("s_waitcnt lgkmcnt(0)\n\ts_barrier" ::: "memory");
        }
        pg8::EpiUpConv E{ACT, conv_w, conv_b, HALO, (LAS f32x4*)(lds + XCH_OFF), (const LAS float*)(lds + RSTD_OFF), pm_base};
        pg8::gemm_phase<pg8::EpiUpConv, pg8::StaticOrder, pg8::Gemm1>(lds + RING_OFF, g, S, E, wave);
        pg8::Unit ux;
        if (G == 256 && !S.next(21, ux)) {
            PHASE_IDS();
            LAS float* scr = (LAS float*)(lds + RING_OFF + wave * 16384);
            const int gwi = (bx - 128) * NWAVES + wave;
            if (bx >= 128) for (int it = gwi; it < 172 * 128; it += 128 * NWAVES) tr_plain(w_down, DFF, 4096, W_DOWN, scr, it, lane);
        }
    }
    xcd_barrier(bar, wave);
    {
        PHASE_IDS();
        const int gt = vcu * (NWAVES * 64) + tid, NGT = G * NWAVES * 64;
        for (int idx = gt; idx < 64 * (DFF / 4); idx += NGT) {
            const int pm = idx / (DFF / 4), ch = (idx - pm * (DFF / 4)) * 4;
            if ((pm & 31) == 0) continue;
            f32x4 yy[2][2];
#pragma unroll
            for (int bj = 0; bj < 2; ++bj) { const int col = bj * DFF + ch;
                const f32x4 um2 = *(const f32x4*)(HALO + (size_t)((pm - 1) * 4 + 2) * NUP + col), um1 = *(const f32x4*)(HALO + (size_t)((pm - 1) * 4 + 3) * NUP + col);
                const f32x4 u0v = *(const f32x4*)(HALO + (size_t)(pm * 4 + 0) * NUP + col), u1v = *(const f32x4*)(HALO + (size_t)(pm * 4 + 1) * NUP + col);
                const f32x4 w0 = *(const f32x4*)(conv_w + col), w1 = *(const f32x4*)(conv_w + NUP + col), w2 = *(const f32x4*)(conv_w + 2 * NUP + col), bb = *(const f32x4*)(conv_b + col);
                yy[bj][0] = w2 * u0v + w1 * um1 + w0 * um2 + bb; yy[bj][1] = w2 * u1v + w1 * u0v + w0 * um1 + bb; }
#pragma unroll
            for (int r = 0; r < 2; ++r) { f32x4 y;
#pragma unroll
                for (int e = 0; e < 4; ++e) { const float gv = yy[0][r][e]; y[e] = gv * sigmoidf_fast(gv) * yy[1][r][e]; }
                u32x2 w; w.x = pk2(y[0], y[1]); w.y = pk2(y[2], y[3]); *(u32x2*)(ACT + (size_t)(pm * 256 + r) * DFF + ch) = w; }
        }
    }
    xcd_barrier(bar, wave);

    {
        pg8::Gemm1 g{ACT, W_DOWN, DFF, DFF, DFF, 0}; pg8::StaticOrder S; S.init(MTOK, DMODEL, G, bx);
        pg8::EpiOut E{X1B, out};
        pg8::gemm_phase<pg8::EpiOut, pg8::StaticOrder, pg8::Gemm1>(lds + RING_OFF, g, S, E, wave);
    }
}

extern "C" void kernel_launch(void* const* d_in, const int* in_sizes, int n_in, void* d_out, int out_size, void* d_ws, size_t ws_size, hipStream_t stream) {
    static int grid = 0;
    if (grid == 0) {
        if (n_in != 26 || in_sizes[0] != MTOK * DMODEL || out_size != MTOK * DMODEL || ws_size < WS_END) {
            fprintf(stderr, "kernel_launch: unexpected shapes: n_in %d in0 %d out %d ws %zu (need %zu)\n", n_in, n_in > 0 ? in_sizes[0] : -1, out_size, ws_size, (size_t)WS_END); grid = -1; return; }
        int dev = 0, cus = 0, per_cu = 0;
        if (hipGetDevice(&dev) != hipSuccess || hipDeviceGetAttribute(&cus, hipDeviceAttributeMultiprocessorCount, dev) != hipSuccess) { grid = -1; return; }
        if (hipFuncSetAttribute((const void*)mk_fwd, hipFuncAttributeMaxDynamicSharedMemorySize, LDS_BYTES) != hipSuccess) { fprintf(stderr, "kernel_launch: hipFuncSetAttribute failed\n"); grid = -1; return; }
        if (hipOccupancyMaxActiveBlocksPerMultiprocessor(&per_cu, (const void*)mk_fwd, NWAVES * 64, LDS_BYTES) != hipSuccess || per_cu < 1)
            fprintf(stderr, "kernel_launch: note: occupancy query reports %d workgroups per CU\n", per_cu);
        (void)hipGetLastError();
        grid = cus;
        if (grid != 256) fprintf(stderr, "kernel_launch: %d CUs; the attention phase is dealt for 256\n", grid);
    }
    if (grid < 0) return;
    if (hipMemsetAsync((char*)d_ws + WS_CTL, 0, CTL_ZERO_BYTES, stream) != hipSuccess) return;
    Args a{};
    for (int i = 0; i < 26; ++i) a.in[i] = (const float*)d_in[i];
    a.out = (float*)d_out; a.ws = (unsigned char*)d_ws;
    hipLaunchKernelGGL(mk_fwd, dim3(grid), dim3(NWAVES * 64), LDS_BYTES, stream, a);
}
```

```cpp
#include <hip/hip_runtime.h>
#include <cstdio>
#include <cstdint>

#define LAS __attribute__((address_space(3)))
#define GAS __attribute__((address_space(1)))
typedef unsigned short bf16_t;
typedef short bf16x8 __attribute__((ext_vector_type(8)));
typedef short s16x4 __attribute__((ext_vector_type(4)));
typedef float f32x2 __attribute__((ext_vector_type(2)));
typedef float f32x4 __attribute__((ext_vector_type(4)));
typedef float f32x16 __attribute__((ext_vector_type(16)));
typedef unsigned u32x2 __attribute__((ext_vector_type(2)));
typedef unsigned u32x4 __attribute__((ext_vector_type(4)));
typedef __bf16 bf16x2_t __attribute__((ext_vector_type(2)));
typedef int v8i32 __attribute__((ext_vector_type(8)));

constexpr int BATCH = 2, SEQ = 8192, DMODEL = 4096, MTOK = BATCH * SEQ;
constexpr int NIN = 20480, DFF = 11008, NUP = 2 * DFF, MEMLEN = 256, MROWS = BATCH * MEMLEN;
constexpr float EPS = 1e-6f, LOG2E = 1.4426950408889634f;
constexpr float LAMBDA_INIT = 0.2f;
constexpr int NWAVES = 8;

constexpr size_t MiB = 1u << 20;
constexpr size_t WS_CTL = 0, CTL_ZERO_BYTES = 32768;
constexpr size_t WS_WUP = 2 * MiB;
constexpr size_t WS_WDOWN = 174 * MiB;
constexpr size_t WS_WIN = 260 * MiB;
constexpr size_t WS_WG8 = 324 * MiB;
constexpr size_t DO_H8 = 128 * MiB;
constexpr size_t WS_WA = 420 * MiB;
constexpr size_t WS_WB = 436 * MiB;
constexpr size_t WS_WC = 444 * MiB;
constexpr size_t WS_WO = 452 * MiB;
constexpr size_t WS_WMKV = 484 * MiB;
constexpr size_t WS_WPOOL = 500 * MiB;
constexpr size_t WS_KVM = 501 * MiB;
constexpr size_t WS_HM = 503 * MiB;
constexpr size_t WS_QA = 508 * MiB, WS_KA = 572 * MiB, WS_VA = 636 * MiB;
constexpr size_t WS_UP = 700 * MiB, WS_QM = 732 * MiB;
constexpr size_t WS_GL = 764 * MiB;
constexpr size_t WS_YP = 1148 * MiB;
constexpr size_t WS_MERGED = 508 * MiB;
constexpr size_t WS_X1B = 260 * MiB;
constexpr size_t WS_ACT = 852 * MiB;
constexpr size_t WS_SSQ = 1196 * MiB;
constexpr size_t WS_HALO = 1200 * MiB;
constexpr size_t WS_WBF = 960 * MiB;
constexpr size_t WS_WPF = 968 * MiB;
constexpr size_t WS_END = 1222 * MiB;
constexpr size_t DO_YA = 192 * MiB, DO_YB = 128 * MiB, DO_YC = 160 * MiB;
constexpr size_t WS_CWS = 1 * MiB + 256 * 1024;
constexpr size_t WS_RS1 = 1 * MiB;

constexpr int CW_TMO = 0;
constexpr int CW_BAR = 4096;
constexpr int CW_P0A = 64;

constexpr int RING_OFF = 0, RING_BYTES = 131072;
constexpr int LDSCTL_OFF = RING_BYTES, MISC_OFF = LDSCTL_OFF + 320;
constexpr int WSF_OFF = RING_BYTES + 1024;
constexpr int XCH_OFF = RING_BYTES + 4096;
constexpr int RSTD_OFF = RING_BYTES + 12288;
constexpr int LDS_BYTES = 155648;

__device__ __forceinline__ float bflo(unsigned w) { return __uint_as_float(w << 16); }
__device__ __forceinline__ float bfhi(unsigned w) { return __uint_as_float(w & 0xffff0000u); }
__device__ __forceinline__ unsigned pk2(float lo, float hi) { f32x2 v = {lo, hi}; bf16x2_t b = __builtin_convertvector(v, bf16x2_t); return __builtin_bit_cast(unsigned, b); }
__device__ __forceinline__ float sigmoidf_fast(float a) { return __builtin_amdgcn_rcpf(1.0f + __builtin_amdgcn_exp2f(-LOG2E * a)); }
template <int K> __device__ __forceinline__ float sx(float v) { return __int_as_float(__builtin_amdgcn_ds_swizzle(__float_as_int(v), (K << 10) | 0x1f)); }
__device__ __forceinline__ float sum32x(float v) { auto rr = __builtin_amdgcn_permlane32_swap(__float_as_uint(v), __float_as_uint(v), false, false); return __uint_as_float(rr[0]) + __uint_as_float(rr[1]); }
__device__ __forceinline__ float max32x(float v) { auto rr = __builtin_amdgcn_permlane32_swap(__float_as_uint(v), __float_as_uint(v), false, false); return fmaxf(__uint_as_float(rr[0]), __uint_as_float(rr[1])); }
__device__ __forceinline__ float wave_sum(float v) { v += sx<1>(v); v += sx<2>(v); v += sx<4>(v); v += sx<8>(v); v += sx<16>(v); return sum32x(v); }
__device__ __forceinline__ float wave_max(float v) { v = fmaxf(v, sx<1>(v)); v = fmaxf(v, sx<2>(v)); v = fmaxf(v, sx<4>(v)); v = fmaxf(v, sx<8>(v)); v = fmaxf(v, sx<16>(v)); return max32x(v); }
__device__ __forceinline__ void unpack8(const u32x4 w, float (&f)[8]) { f[0] = bflo(w.x); f[1] = bfhi(w.x); f[2] = bflo(w.y); f[3] = bfhi(w.y); f[4] = bflo(w.z); f[5] = bfhi(w.z); f[6] = bflo(w.w); f[7] = bfhi(w.w); }
__device__ __forceinline__ unsigned pk4_fp8(float a, float b, float c, float d) { int p = __builtin_amdgcn_cvt_pk_fp8_f32(a, b, 0, false); p = __builtin_amdgcn_cvt_pk_fp8_f32(c, d, p, true); return (unsigned)p; }
__device__ __forceinline__ void gate_unpack8(const u32x2 w, float (&f)[8]) { f[0] = (float)(w.x & 0xffu); f[1] = (float)((w.x >> 8) & 0xffu); f[2] = (float)((w.x >> 16) & 0xffu); f[3] = (float)(w.x >> 24);
                                                                            f[4] = (float)(w.y & 0xffu); f[5] = (float)((w.y >> 8) & 0xffu); f[6] = (float)((w.y >> 16) & 0xffu); f[7] = (float)(w.y >> 24); }
#define LDS_WAIT() asm volatile("s_waitcnt lgkmcnt(0)" ::: "memory")
#define VM_WAIT() asm volatile("s_waitcnt vmcnt(0)" ::: "memory")

namespace pg8 {
constexpr int BM = 256, BK = 64, HALF = 128, HTB = HALF * BK * 2, STAGE_BYTES = 8 * HTB, NXCD = 8, WGM = 8;
__host__ __device__ __forceinline__ int lds_byte(int r, int c) { const int st = (r >> 4) * 2 + (c >> 5), rr = r & 15, cc = c & 31, ob = rr * 64 + cc * 2; return st * 1024 + (ob ^ (((ob >> 9) & 1) << 5)); }
__host__ __device__ __forceinline__ void stage_rc(int b, int& R, int& C) { const int st = b / 1024, sb = b % 1024, swz = sb ^ (((sb >> 9) & 1) << 5); R = (st >> 1) * 16 + swz / 64; C = (st & 1) * 32 + (swz % 64) / 2; }
__host__ __device__ __forceinline__ int lds_byte2(int r, int c) { const int rr = r & 7, q = c >> 3; return (r >> 3) * 1024 + rr * 128 + ((q ^ (((rr >> 1) & 3) << 1)) << 4); }
__host__ __device__ __forceinline__ void stage_rc2(int b, int& R, int& C) { const int blk = b / 1024, sb = b % 1024, rr = sb / 128, pos = (sb % 128) / 16; R = blk * 8 + rr; C = (pos ^ (((rr >> 1) & 3) << 1)) * 8; }
__host__ __device__ __forceinline__ int perm32(int rho) { const int n = rho >> 4, i = rho & 15; return 8 * (i >> 2) + 4 * n + (i & 3); }

struct Unit { int pm, pn; };

struct StaticOrder {
    int nM, nN, nwg, G, c;
    __device__ void init(int M, int N, int G_, int c_) { nM = M / BM; nN = N / BM; nwg = nM * nN; G = G_; c = c_; }
    __device__ bool next(int i, Unit& u) const {
        const long L = (long)i * G + c; if (L >= nwg) return false;
        int wgid = (int)L; { const int q = nwg / NXCD, r = nwg % NXCD, xcd = wgid % NXCD, off = wgid / NXCD; wgid = (xcd < r ? xcd * (q + 1) : r * (q + 1) + (xcd - r) * q) + off; }
        const int nig = WGM * nN, gid = wgid / nig, fm = gid * WGM, gsz = (nM - fm) < WGM ? (nM - fm) : WGM;
        u.pm = fm + ((wgid % nig) % gsz); u.pn = (wgid % nig) / gsz; return true;
    }
};

typedef f32x4 Acc[2][2][4][2];

struct TileOut { bf16_t* base; int ld, colt, mode; const float* g; float scale; };
__device__ __forceinline__ void norm_store(Acc& acc, const Unit& u, const TileOut t, LAS float* xch, const float* inv2pi, int wr, int wc, int fr, int fq) {
    asm volatile("" : "+v"(fq), "+v"(fr));
    const int lrow = wr * 64 + fr;
    if (t.mode >= 2) {
        f32x4 gv[2][2];
#pragma unroll
        for (int bj = 0; bj < 2; ++bj)
#pragma unroll
            for (int n = 0; n < 2; ++n) gv[bj][n] = *(const f32x4*)(t.g + (t.mode == 3 ? bj * HALF : 0) + wc * 32 + 8 * fq + 4 * n);
#pragma unroll
        for (int ai = 0; ai < 2; ++ai)
#pragma unroll
            for (int m = 0; m < 4; ++m)
#pragma unroll
                for (int bj = 0; bj < 2; ++bj) { const f32x4 a = acc[ai][bj][m][0], b = acc[ai][bj][m][1];
                    float q = (a[0] * a[0] + a[1] * a[1]) + (a[2] * a[2] + a[3] * a[3]) + (b[0] * b[0] + b[1] * b[1]) + (b[2] * b[2] + b[3] * b[3]);
                    q += sx<16>(q); q = sum32x(q);
                    if (fq == 0) xch[((lrow + ai * HALF + m * 16) * 2 + bj) * 4 + wc] = q; }
        asm volatile("s_waitcnt lgkmcnt(0)\n\ts_barrier" ::: "memory");
#pragma unroll
        for (int ai = 0; ai < 2; ++ai)
#pragma unroll
            for (int m = 0; m < 4; ++m) {
                const f32x4 p0 = *(const LAS f32x4*)(xch + ((lrow + ai * HALF + m * 16) * 2 + 0) * 4), p1 = *(const LAS f32x4*)(xch + ((lrow + ai * HALF + m * 16) * 2 + 1) * 4);
                const float s0 = (p0[0] + p0[1]) + (p0[2] + p0[3]), s1 = (p1[0] + p1[1]) + (p1[2] + p1[3]);
                float r0, r1;
                if (t.mode == 3) { r0 = r1 = t.scale * __builtin_amdgcn_rsqf((s0 + s1) * (1.f / 256.f) + EPS); } else { r0 = __builtin_amdgcn_rsqf(s0 * (1.f / 128.f) + EPS); r1 = __builtin_amdgcn_rsqf(s1 * (1.f / 128.f) + EPS); }
#pragma unroll
                for (int n = 0; n < 2; ++n) { acc[ai][0][m][n] = acc[ai][0][m][n] * r0 * gv[0][n]; acc[ai][1][m][n] = acc[ai][1][m][n] * r1 * gv[1][n]; } }
        if (t.mode == 2) {
            if (wc == 0) {
                f32x4 iv[2];
#pragma unroll
                for (int n = 0; n < 2; ++n) iv[n] = *(const f32x4*)(inv2pi + 8 * (fq & 1) + 4 * n);
                const float sgn = (fq < 2) ? -1.0f : 1.0f;
#pragma unroll
                for (int ai = 0; ai < 2; ++ai)
#pragma unroll
                    for (int m = 0; m < 4; ++m) { const float fp = (float)((u.pm * BM + lrow + ai * HALF + m * 16) & (SEQ - 1));
#pragma unroll
                        for (int n = 0; n < 2; ++n)
#pragma unroll
                            for (int e = 0; e < 4; ++e) { const float rev = __builtin_amdgcn_fractf(fp * iv[n][e]); const float c = __builtin_amdgcn_cosf(rev), sn = __builtin_amdgcn_sinf(rev) * sgn;
#pragma unroll
                                for (int bj = 0; bj < 2; ++bj) { const float v = acc[ai][bj][m][n][e];
                                    auto rr = __builtin_amdgcn_permlane32_swap(__float_as_uint(v), __float_as_uint(v), false, false);
                                    const float other = __uint_as_float(fq < 2 ? rr[1] : rr[0]);
                                    acc[ai][bj][m][n][e] = v * c + other * sn; } } }
            }
#pragma unroll
            for (int ai = 0; ai < 2; ++ai)
#pragma unroll
                for (int m = 0; m < 4; ++m)
#pragma unroll
                    for (int bj = 0; bj < 2; ++bj)
#pragma unroll
                        for (int n = 0; n < 2; ++n) acc[ai][bj][m][n] = acc[ai][bj][m][n] * t.scale;
        }
    }
    const int row0 = u.pm * BM + lrow, col0 = t.colt + wc * 32 + 8 * fq;
#pragma unroll
    for (int ai = 0; ai < 2; ++ai)
#pragma unroll
        for (int m = 0; m < 4; ++m) { bf16_t* rowp = t.base + (size_t)(row0 + ai * HALF + m * 16) * t.ld + col0;
#pragma unroll
            for (int bj = 0; bj < 2; ++bj) { f32x4 v0 = acc[ai][bj][m][0], v1 = acc[ai][bj][m][1];
                if (t.mode == 1) {
#pragma unroll
                    for (int e = 0; e < 4; ++e) { v0[e] = sigmoidf_fast(v0[e]); v1[e] = sigmoidf_fast(v1[e]); } }
                u32x4 w; w.x = pk2(v0[0], v0[1]); w.y = pk2(v0[2], v0[3]); w.z = pk2(v1[0], v1[1]); w.w = pk2(v1[2], v1[3]);
                *(u32x4*)(rowp + bj * HALF) = w; } }
}
struct EpiProj {
    static constexpr bool PERM = true;
    bf16_t* qa; bf16_t* up; bf16_t* qm; bf16_t* gl;
    const LAS float* rs; int pm_base;
    const float* g_qa; const float* g_ka; const float* g_qm; LAS float* xch; const float* inv2pi;
    __device__ __forceinline__ void operator()(Acc& acc, const Unit& u, int wr, int wc, int fr, int fq) const {
        { const LAS float* rp = rs + (u.pm - pm_base) * BM + wr * 64 + fr; float r8[8];
#pragma unroll
          for (int i = 0; i < 8; ++i) r8[i] = rp[(i >> 2) * HALF + (i & 3) * 16];
#pragma unroll
          for (int ai = 0; ai < 2; ++ai)
#pragma unroll
              for (int m = 0; m < 4; ++m)
#pragma unroll
                  for (int bj = 0; bj < 2; ++bj)
#pragma unroll
                      for (int n = 0; n < 2; ++n) acc[ai][bj][m][n] *= r8[ai * 4 + m]; }
        const int pn = u.pn; TileOut t;
        if (pn < 8) { t.base = qa; t.ld = 2048; t.colt = pn * 256; t.mode = 2; t.g = g_qa; t.scale = 0.08838834764831845f * LOG2E; }
        else if (pn < 16) { t.base = qa + (size_t)MTOK * 2048; t.ld = 2048; t.colt = (pn - 8) * 256; t.mode = 2; t.g = g_ka; t.scale = 1.0f; }
        else if (pn < 24) { t.base = qa + (size_t)2 * MTOK * 2048; t.ld = 2048; t.colt = (pn - 16) * 256; t.mode = 0; t.g = nullptr; t.scale = 1.0f; }
        else if (pn < 28) { t.base = up; t.ld = 1024; t.colt = (pn - 24) * 256; t.mode = 0; t.g = nullptr; t.scale = 1.0f; }
        else if (pn < 32) { t.base = qm; t.ld = 1024; t.colt = (pn - 28) * 256; t.mode = 3; t.g = g_qm; t.scale = 0.0625f * LOG2E; }
        else { t.base = gl; t.ld = 12288; t.colt = (pn - 32) * 256; t.mode = 1; t.g = nullptr; t.scale = 1.0f; }
        norm_store(acc, u, t, xch, inv2pi, wr, wc, fr, fq);
    }
};
struct EpiG8 {
    static constexpr bool PERM = true;
    unsigned char* gl; bf16_t* qm; const float* g_qm; LAS float* xch;
    __device__ __forceinline__ void operator()(Acc& acc, const Unit& u, int wr, int wc, int fr, int fq) const {
        if (u.pn < 4) {
#pragma unroll
            for (int ai = 0; ai < 2; ++ai)
#pragma unroll
                for (int bj = 0; bj < 2; ++bj)
#pragma unroll
                    for (int m = 0; m < 4; ++m)
#pragma unroll
                        for (int n = 0; n < 2; ++n) acc[ai][bj][m][n] = acc[ai][bj][m][n] * 0.015625f;
            TileOut t; t.base = qm; t.ld = 1024; t.colt = u.pn * 256; t.mode = 3; t.g = g_qm; t.scale = 0.0625f * LOG2E;
            norm_store(acc, u, t, xch, nullptr, wr, wc, fr, fq);
            return;
        }
        unsigned char* tp = gl + ((size_t)(u.pm * 48 + (u.pn - 4)) << 16) + (wr * 4 + wc) * 8192 + (fq * 16 + fr) * 16;
#pragma unroll
        for (int ai = 0; ai < 2; ++ai)
#pragma unroll
            for (int m = 0; m < 4; ++m) { u32x4 w4;
#pragma unroll
                for (int bj = 0; bj < 2; ++bj) { const f32x4 v0 = acc[ai][bj][m][0], v1 = acc[ai][bj][m][1];
                    unsigned lo = 0u, hi = 0u;
#pragma unroll
                    for (int e = 0; e < 4; ++e) {
                        const float q0 = __builtin_amdgcn_rcpf((1.0f / 255.0f) + __builtin_amdgcn_exp2f(__builtin_fmaf(v0[e], -LOG2E * 0.015625f, -7.99435343685886f)));
                        const float q1 = __builtin_amdgcn_rcpf((1.0f / 255.0f) + __builtin_amdgcn_exp2f(__builtin_fmaf(v1[e], -LOG2E * 0.015625f, -7.99435343685886f)));
                        lo = __builtin_amdgcn_cvt_pk_u8_f32(fmaxf(q0 + 0.5f, 1.0f), e, lo); hi = __builtin_amdgcn_cvt_pk_u8_f32(fmaxf(q1 + 0.5f, 1.0f), e, hi); }
                    if (bj == 0) { w4.x = lo; w4.y = hi; } else { w4.z = lo; w4.w = hi; } }
                *(u32x4*)(tp + (ai * 4 + m) * 1024) = w4; }
    }
};
struct EpiKvm {
    static constexpr bool PERM = true;
    bf16_t* kvm; const float* g_km; LAS float* xch;
    __device__ __forceinline__ void operator()(Acc& acc, const Unit& u, int wr, int wc, int fr, int fq) const {
        TileOut t; t.base = kvm; t.ld = 2048; t.colt = u.pn * 256; t.mode = (u.pn < 4) ? 3 : 0; t.g = g_km; t.scale = 1.0f;
        norm_store(acc, u, t, xch, nullptr, wr, wc, fr, fq);
    }
};
struct EpiBf16 {
    static constexpr bool PERM = true;
    bf16_t* O; int ldc; const float* colscale;
    __device__ __forceinline__ void operator()(const Acc& acc, const Unit& u, int wr, int wc, int fr, int fq) const {
        const int row0 = u.pm * BM + wr * 64 + fr, col0 = u.pn * BM + wc * 32 + 8 * fq;
        f32x4 sv[2][2];
#pragma unroll
        for (int bj = 0; bj < 2; ++bj)
#pragma unroll
            for (int n = 0; n < 2; ++n) sv[bj][n] = colscale ? *(const f32x4*)(colscale + col0 + bj * HALF + 4 * n) : (f32x4){1.f, 1.f, 1.f, 1.f};
#pragma unroll
        for (int ai = 0; ai < 2; ++ai)
#pragma unroll
            for (int m = 0; m < 4; ++m) { bf16_t* rowp = O + (size_t)(row0 + ai * HALF + m * 16) * ldc + col0;
#pragma unroll
                for (int bj = 0; bj < 2; ++bj) { const f32x4 v0 = acc[ai][bj][m][0] * sv[bj][0], v1 = acc[ai][bj][m][1] * sv[bj][1];
                    u32x4 w; w.x = pk2(v0[0], v0[1]); w.y = pk2(v0[2], v0[3]); w.z = pk2(v1[0], v1[1]); w.w = pk2(v1[2], v1[3]);
                    *(u32x4*)(rowp + bj * HALF) = w; } }
    }
};
struct EpiMerge {
    static constexpr bool PERM = true;
    bf16_t* O; const unsigned char* gate;
    __device__ __forceinline__ void mid(Acc& acc, const Unit& u, int s, int wr, int wc, int fr, int fq) const {
        int lo = (wr * 4 + wc) * 8192 + (fq * 16 + fr) * 16; asm volatile("" : "+v"(lo));
        const unsigned char* gp = gate + ((size_t)(u.pm * 48 + s * 16 + u.pn) << 16) + lo;
        u32x4 G[8][2];
#pragma unroll
        for (int i = 0; i < 8; ++i) { G[i][0] = __builtin_nontemporal_load((const u32x4*)(gp + i * 1024)); G[i][1] = __builtin_nontemporal_load((const u32x4*)(gp + (1 << 20) + i * 1024)); }
#pragma unroll
        for (int i = 0; i < 8; ++i) { const int ai = i >> 2, m = i & 3;
#pragma unroll
            for (int bj = 0; bj < 2; ++bj) {
                const u32x4 ga = G[i][0], gb = G[i][1];
                const u32x2 wa = bj == 0 ? (u32x2){ga.x, ga.y} : (u32x2){ga.z, ga.w}, wb = bj == 0 ? (u32x2){gb.x, gb.y} : (u32x2){gb.z, gb.w};
                float fa[8], fb[8]; gate_unpack8(wa, fa); gate_unpack8(wb, fb);
#pragma unroll
                for (int e = 0; e < 8; ++e) fa[e] = fa[e] * __builtin_amdgcn_rcpf(fb[e]);
                f32x4& v0 = acc[ai][bj][m][0]; f32x4& v1 = acc[ai][bj][m][1];
                v0[0] *= fa[0]; v0[1] *= fa[1]; v0[2] *= fa[2]; v0[3] *= fa[3]; v1[0] *= fa[4]; v1[1] *= fa[5]; v1[2] *= fa[6]; v1[3] *= fa[7]; }
            __builtin_amdgcn_sched_barrier(0); }
    }
    __device__ __forceinline__ void operator()(const Acc& acc, const Unit& u, int wr, int wc, int fr, int fq) const {
        const int row0 = u.pm * BM + wr * 64 + fr, col0 = u.pn * BM + wc * 32 + 8 * fq;
        const unsigned char* gp = gate + ((size_t)(u.pm * 48 + 32 + u.pn) << 16) + (wr * 4 + wc) * 8192 + (fq * 16 + fr) * 16;
        u32x4 G2[8];
#pragma unroll
        for (int i = 0; i < 8; ++i) G2[i] = __builtin_nontemporal_load((const u32x4*)(gp + i * 1024));
        __builtin_amdgcn_sched_barrier(0);
#pragma unroll
        for (int ai = 0; ai < 2; ++ai)
#pragma unroll
            for (int m = 0; m < 4; ++m) { const size_t r = (size_t)(row0 + ai * HALF + m * 16);
                const u32x4 g4 = G2[ai * 4 + m];
#pragma unroll
                for (int bj = 0; bj < 2; ++bj) {
                    const u32x2 gw = bj == 0 ? (u32x2){g4.x, g4.y} : (u32x2){g4.z, g4.w};
                    float fg[8]; gate_unpack8(gw, fg);
#pragma unroll
                    for (int e = 0; e < 8; ++e) fg[e] *= (1.0f / 255.0f);
                    const f32x4 v0 = acc[ai][bj][m][0], v1 = acc[ai][bj][m][1];
                    u32x4 w; w.x = pk2(v0[0] * fg[0], v0[1] * fg[1]); w.y = pk2(v0[2] * fg[2], v0[3] * fg[3]); w.z = pk2(v1[0] * fg[4], v1[1] * fg[5]); w.w = pk2(v1[2] * fg[6], v1[3] * fg[7]);
                    *(u32x4*)(O + r * 4096 + col0 + bj * HALF) = w; } }
    }
};
struct EpiX1 {
    static constexpr bool PERM = true;
    const bf16_t* base; bf16_t* xb; float* ssq;
    __device__ __forceinline__ void operator()(const Acc& acc, const Unit& u, int wr, int wc, int fr, int fq) const {
        const int row0 = u.pm * BM + wr * 64 + fr, col0 = u.pn * BM + wc * 32 + 8 * fq;
        u32x4 X[8];
#define X1_LOAD(slot, s_) X[slot] = __builtin_nontemporal_load((const u32x4*)(base + (size_t)(row0 + ((s_) >> 3) * HALF + (((s_) >> 1) & 3) * 16) * DMODEL + col0 + ((s_) & 1) * HALF))
#pragma unroll
        for (int s_ = 0; s_ < 8; ++s_) X1_LOAD(s_, s_);
        __builtin_amdgcn_sched_barrier(0);
        float q = 0.f;
#pragma unroll
        for (int s_ = 0; s_ < 16; ++s_) { const int ai = s_ >> 3, m = (s_ >> 1) & 3, bj = s_ & 1;
            const int row = row0 + ai * HALF + m * 16; const size_t off = (size_t)row * DMODEL + col0;
            const u32x4 rw = X[s_ & 7];
            if (s_ + 8 < 16) X1_LOAD(s_ & 7, s_ + 8);
            f32x4 v0 = acc[ai][bj][m][0], v1 = acc[ai][bj][m][1];
            v0[0] += bflo(rw.x); v0[1] += bfhi(rw.x); v0[2] += bflo(rw.y); v0[3] += bfhi(rw.y); v1[0] += bflo(rw.z); v1[1] += bfhi(rw.z); v1[2] += bflo(rw.w); v1[3] += bfhi(rw.w);
            u32x4 w; w.x = pk2(v0[0], v0[1]); w.y = pk2(v0[2], v0[3]); w.z = pk2(v1[0], v1[1]); w.w = pk2(v1[2], v1[3]); *(u32x4*)(xb + off + bj * HALF) = w;
            q += ((v0[0] * v0[0] + v0[1] * v0[1]) + (v0[2] * v0[2] + v0[3] * v0[3])) + ((v1[0] * v1[0] + v1[1] * v1[1]) + (v1[2] * v1[2] + v1[3] * v1[3]));
            if (bj == 1) { q += sx<16>(q); q = sum32x(q);
                if (fq == 0) ssq[(size_t)row * 64 + u.pn * 4 + wc] = q;
                q = 0.f; }
            __builtin_amdgcn_sched_barrier(0); }
#undef X1_LOAD
    }
};
struct EpiOut {
    static constexpr bool PERM = true;
    const bf16_t* resid; float* out;
    __device__ __forceinline__ void operator()(const Acc& acc, const Unit& u, int wr, int wc, int fr, int fq) const {
        const int row0 = u.pm * BM + wr * 64 + fr, col0 = u.pn * BM + wc * 32 + 8 * fq;
        u32x4 R[16];
#pragma unroll
        for (int s_ = 0; s_ < 16; ++s_) R[s_] = __builtin_nontemporal_load((const u32x4*)(resid + (size_t)(row0 + (s_ >> 3) * HALF + ((s_ >> 1) & 3) * 16) * DMODEL + col0 + (s_ & 1) * HALF));
        __builtin_amdgcn_sched_barrier(0);
#pragma unroll
        for (int ai = 0; ai < 2; ++ai)
#pragma unroll
            for (int m = 0; m < 4; ++m) { const size_t off = (size_t)(row0 + ai * HALF + m * 16) * DMODEL + col0;
#pragma unroll
                for (int bj = 0; bj < 2; ++bj) { const u32x4 rw = R[(ai * 4 + m) * 2 + bj];
                    f32x4 o0 = acc[ai][bj][m][0], o1 = acc[ai][bj][m][1];
                    o0[0] += bflo(rw.x); o0[1] += bfhi(rw.x); o0[2] += bflo(rw.y); o0[3] += bfhi(rw.y); o1[0] += bflo(rw.z); o1[1] += bfhi(rw.z); o1[2] += bflo(rw.w); o1[3] += bfhi(rw.w);
                    *(f32x4*)(out + off + bj * HALF) = o0; *(f32x4*)(out + off + bj * HALF + 4) = o1; } }
    }
};
template <int CTRL> __device__ __forceinline__ float dpp_f(float old, float src) { return __int_as_float(__builtin_amdgcn_update_dpp(__float_as_int(old), __float_as_int(src), CTRL, 0xf, 0xf, false)); }
template <int CTRL> __device__ __forceinline__ float dppz_f(float src) { return __int_as_float(__builtin_amdgcn_update_dpp(0, __float_as_int(src), CTRL, 0xf, 0xf, true)); }
struct EpiUpConv {
    static constexpr bool PERM = true;
    bf16_t* act; const float* conv_w; const float* conv_b; float* halo; LAS f32x4* xch; const LAS float* rstd; int pm_base;
    __device__ __forceinline__ void operator()(Acc& acc, const Unit& u, int wr, int wc, int fr, int fq) const {
        const int ch = u.pn * 128 + wc * 32 + 8 * fq;
        const LAS float* rs = rstd + (u.pm - pm_base) * 256 + wr * 64 + fr;
#pragma unroll
        for (int ai = 0; ai < 2; ++ai)
#pragma unroll
            for (int m = 0; m < 4; ++m) { const float r = rs[ai * HALF + m * 16];
#pragma unroll
                for (int bj = 0; bj < 2; ++bj)
#pragma unroll
                    for (int n = 0; n < 2; ++n) acc[ai][bj][m][n] *= r; }
        f32x4 CW[2][4];
#define CW_LOAD(buf, g) do { const int col_ = ((g) >> 1) * DFF + ch + 4 * ((g) & 1); \
            CW[buf][0] = *(const f32x4*)(conv_w + col_); CW[buf][1] = *(const f32x4*)(conv_w + NUP + col_); CW[buf][2] = *(const f32x4*)(conv_w + 2 * NUP + col_); CW[buf][3] = *(const f32x4*)(conv_b + col_); } while (0)
        CW_LOAD(0, 0);
        if (fr >= 14) {
#pragma unroll
            for (int ai = 0; ai < 2; ++ai)
#pragma unroll
                for (int bj = 0; bj < 2; ++bj)
#pragma unroll
                    for (int n = 0; n < 2; ++n) xch[((((ai * 2 + wr) * 4 + wc) * 2 + (fr - 14)) * 4 + fq) * 4 + bj * 2 + n] = acc[ai][bj][3][n];
        }
        if (wr == 0 && fr < 2) {
#pragma unroll
            for (int bj = 0; bj < 2; ++bj)
#pragma unroll
                for (int n = 0; n < 2; ++n) *(f32x4*)(halo + (size_t)(u.pm * 4 + fr) * NUP + bj * DFF + ch + 4 * n) = acc[0][bj][0][n];
        }
        if (wr == 1 && fr >= 14) {
#pragma unroll
            for (int bj = 0; bj < 2; ++bj)
#pragma unroll
                for (int n = 0; n < 2; ++n) *(f32x4*)(halo + (size_t)(u.pm * 4 + 2 + (fr - 14)) * NUP + bj * DFF + ch + 4 * n) = acc[1][bj][3][n];
        }
        asm volatile("s_waitcnt lgkmcnt(0)\n\ts_barrier" ::: "memory");
#pragma unroll
        for (int bj = 0; bj < 2; ++bj)
#pragma unroll
            for (int n = 0; n < 2; ++n) {
                const int gi = bj * 2 + n;
                if (gi + 1 < 4) CW_LOAD((gi + 1) & 1, gi + 1);
                const f32x4 w0 = CW[gi & 1][0], w1 = CW[gi & 1][1], w2 = CW[gi & 1][2], bb = CW[gi & 1][3];
                const f32x4 w1z = (fr == 0) ? w1 : (f32x4){0.f, 0.f, 0.f, 0.f}, w0z = (fr < 2) ? w0 : (f32x4){0.f, 0.f, 0.f, 0.f};
#pragma unroll
                for (int ai = 0; ai < 2; ++ai) {
                    const bool has = (wr == 1) || (ai == 1);
                    const int pai = (wr == 1) ? ai : 0, pwr = (wr == 1) ? 0 : 1;
                    f32x4 P = (f32x4){0.f, 0.f, 0.f, 0.f};
                    if (has && fr >= 14) P = xch[((((pai * 2 + pwr) * 4 + wc) * 2 + (fr - 14)) * 4 + fq) * 4 + bj * 2 + n];
#pragma unroll
                    for (int m = 3; m >= 0; --m) {
                        const f32x4 cur = acc[ai][bj][m][n]; const f32x4 prv = (m > 0) ? acc[ai][bj][m - 1][n] : P; f32x4 y;
#pragma unroll
                        for (int e = 0; e < 4; ++e) {
                            float t = w2[e] * cur[e] + bb[e];
                            asm("v_fmac_f32_dpp %0, %1, %2 row_shr:1 row_mask:0xf bank_mask:0xf bound_ctrl:1" : "+v"(t) : "v"(cur[e]), "v"(w1[e]));
                            asm("v_fmac_f32_dpp %0, %1, %2 row_shr:2 row_mask:0xf bank_mask:0xf bound_ctrl:1" : "+v"(t) : "v"(cur[e]), "v"(w0[e]));
                            asm("v_fmac_f32_dpp %0, %1, %2 row_ror:1 row_mask:0xf bank_mask:0xf" : "+v"(t) : "v"(prv[e]), "v"(w1z[e]));
                            asm("v_fmac_f32_dpp %0, %1, %2 row_ror:2 row_mask:0xf bank_mask:0xf" : "+v"(t) : "v"(prv[e]), "v"(w0z[e]));
                            y[e] = t; }
                        acc[ai][bj][m][n] = y; } }
                asm volatile("" ::: "memory");
#pragma unroll
                for (int ai = 0; ai < 2; ++ai)
#pragma unroll
                    for (int m = 0; m < 4; ++m) asm volatile("" : "+v"(acc[ai][bj][m][n]));
            }
#undef CW_LOAD
        const int row0 = u.pm * BM + wr * 64 + fr;
#pragma unroll
        for (int ai = 0; ai < 2; ++ai)
#pragma unroll
            for (int m = 0; m < 4; ++m) { f32x4 y0, y1;
#pragma unroll
                for (int e = 0; e < 4; ++e) { const float g0 = acc[ai][0][m][0][e], g1 = acc[ai][0][m][1][e];
                    y0[e] = g0 * __builtin_amdgcn_rcpf(1.0f + __builtin_amdgcn_exp2f(g0)) * acc[ai][1][m][0][e]; y1[e] = g1 * __builtin_amdgcn_rcpf(1.0f + __builtin_amdgcn_exp2f(g1)) * acc[ai][1][m][1][e]; }
                u32x4 w; w.x = pk2(y0[0], y0[1]); w.y = pk2(y0[2], y0[3]); w.z = pk2(y1[0], y1[1]); w.w = pk2(y1[2], y1[3]);
                *(u32x4*)(act + (size_t)(row0 + ai * HALF + m * 16) * DFF + ch) = w; }
    }
};

struct Seg { const char* A; const char* B; int lda, ldb, nt; };
struct Gemm1 {
    static constexpr int NSEG = 1; static constexpr bool FP8 = false, UNIFORM = true;
    const bf16_t* A; const bf16_t* Bt; int lda, ldb, K, a_pn_off;
    __device__ __forceinline__ Seg seg(const Unit& u, int) const { Seg s; s.A = (const char*)(A + (size_t)u.pm * BM * lda + (size_t)u.pn * a_pn_off); s.B = (const char*)(Bt + (size_t)u.pn * BM * ldb); s.lda = lda; s.ldb = ldb; s.nt = K / BK; return s; }
};
struct Gemm8 {
    static constexpr int NSEG = 1; static constexpr bool FP8 = true, UNIFORM = true;
    const unsigned char* A; const unsigned char* Bt; int kbytes;
    __device__ __forceinline__ Seg seg(const Unit& u, int) const { Seg s; s.A = (const char*)(A + (size_t)u.pm * BM * kbytes); s.B = (const char*)(Bt + (size_t)u.pn * BM * kbytes); s.lda = kbytes / 2; s.ldb = kbytes / 2; s.nt = kbytes / 128; return s; }
};
struct Gemm3 {
    static constexpr int NSEG = 3; static constexpr bool FP8 = false, UNIFORM = false;
    const bf16_t* A[3]; const bf16_t* Bt[3]; int K[3];
    __device__ __forceinline__ Seg seg(const Unit& u, int i) const { const bf16_t* a = i == 0 ? A[0] : (i == 1 ? A[1] : A[2]); const bf16_t* b = i == 0 ? Bt[0] : (i == 1 ? Bt[1] : Bt[2]); const int k = i == 0 ? K[0] : (i == 1 ? K[1] : K[2]);
        Seg s; s.A = (const char*)(a + (size_t)u.pm * BM * k); s.B = (const char*)(b + (size_t)u.pn * BM * k); s.lda = k; s.ldb = k; s.nt = k / BK; return s; }
};

template <class Epi, class Sched, class GemmT>
__device__ __forceinline__ void gemm_phase(LAS unsigned char* lds, const GemmT& g, const Sched& S, const Epi& E, const int wid) {
    int lane = (int)__builtin_amdgcn_mbcnt_hi(~0u, __builtin_amdgcn_mbcnt_lo(~0u, 0u)); asm volatile("" : "+v"(lane));
    const int tid = wid * 64 + lane, wr = wid >> 2, wc = wid & 3, fr = lane & 15, fq = lane >> 4;
    constexpr int NSEG = GemmT::NSEG;
    int RA[2], RB[2], CC[2];
#pragma unroll
    for (int i = 0; i < 2; ++i) { int R, C; stage_rc2(tid * 16 + i * 8192, R, C); RA[i] = R; RB[i] = Epi::PERM ? ((R & ~31) + perm32(R & 31)) : R; CC[i] = C; }
    const size_t kstep = (size_t)(BK * 2);
    const unsigned ldsw = (unsigned)wid * 1024u;
    const int aoffk[2] = {lds_byte2(wr * 64 + fr, fq * 8), lds_byte2(wr * 64 + fr, 32 + fq * 8)}, boffk[2] = {lds_byte2(wc * 32 + fr, fq * 8), lds_byte2(wc * 32 + fr, 32 + fq * 8)};
#define PG8_SA(b, h) (((b) * 2 + (h)) * HTB)
#define PG8_SB(b, h) ((4 + (b) * 2 + (h)) * HTB)
#define PG8_STAGE(bufoff, gbase, voff) do { _Pragma("unroll") for (int _i = 0; _i < 2; ++_i) \
        __builtin_amdgcn_global_load_lds((const unsigned*)((const char*)(gbase) + (voff)[_i]), (LAS unsigned*)(lds + (bufoff) + ldsw + _i * 8192), 16, 0, 0); } while (0)
#define PG8_LDA(dst, b, h) do { _Pragma("unroll") for (int m = 0; m < 4; ++m) _Pragma("unroll") for (int k = 0; k < 2; ++k) dst[m][k] = *(const LAS bf16x8*)(lds + PG8_SA(b, h) + aoffk[k] + m * 2048); } while (0)
#define PG8_LDB(dst, b, h) do { _Pragma("unroll") for (int n = 0; n < 2; ++n) _Pragma("unroll") for (int k = 0; k < 2; ++k) dst[n][k] = *(const LAS bf16x8*)(lds + PG8_SB(b, h) + boffk[k] + n * 2048); } while (0)
#define PG8_CAT(x) __builtin_bit_cast(v8i32, __builtin_shufflevector(x[0], x[1], 0, 1, 2, 3, 4, 5, 6, 7, 8, 9, 10, 11, 12, 13, 14, 15))
#define PG8_MMA(ai, bj, At, Bt) do { __builtin_amdgcn_s_setprio(1); _Pragma("unroll") for (int m = 0; m < 4; ++m) _Pragma("unroll") for (int n = 0; n < 2; ++n) { \
        if constexpr (GemmT::FP8) asm("v_mfma_scale_f32_16x16x128_f8f6f4 %0, %1, %2, %0, %3, %3 op_sel_hi:[0,0,0]" : "+v"(acc[ai][bj][m][n]) : "v"(PG8_CAT(Bt[n])), "v"(PG8_CAT(At[m])), "v"(sc8));     \
        else { _Pragma("unroll") for (int k = 0; k < 2; ++k) acc[ai][bj][m][n] = __builtin_amdgcn_mfma_f32_16x16x32_bf16(Bt[n][k], At[m][k], acc[ai][bj][m][n], 0, 0, 0); } } __builtin_amdgcn_s_setprio(0); } while (0)
#define PG8_WAIT_V(n) asm volatile("s_waitcnt vmcnt(" #n ")" ::: "memory")
#define PG8_WAIT_L(n) asm volatile("s_waitcnt lgkmcnt(" #n ")" ::: "memory")
#define PG8_BAR __builtin_amdgcn_s_barrier()
#define PG8_SCHED __builtin_amdgcn_sched_barrier(0)
#define PG8_VOFFS(vA, vB, hA, hB, sg) do { _Pragma("unroll") for (int _i = 0; _i < 2; ++_i) { vA[_i] = (unsigned)(RA[_i] * (sg).lda + CC[_i]) * 2u; vB[_i] = (unsigned)(RB[_i] * (sg).ldb + CC[_i]) * 2u; } \
        hA = (size_t)HALF * (sg).lda * 2; hB = (size_t)HALF * (sg).ldb * 2; } while (0)
    Unit cur, nxt; int ui = 0;
    if (!S.next(0, cur)) return;
    Acc acc;
#pragma unroll
    for (int a = 0; a < 2; ++a)
#pragma unroll
        for (int b = 0; b < 2; ++b)
#pragma unroll
            for (int m = 0; m < 4; ++m)
#pragma unroll
                for (int n = 0; n < 2; ++n) acc[a][b][m][n] = (f32x4){0.f, 0.f, 0.f, 0.f};
    bf16x8 At[4][2], B0[2][2], B1[2][2];
    const int sc8 = 0x7f7f7f7f; (void)sc8;
    Seg cs = g.seg(cur, 0);
    unsigned voffA[2], voffB[2]; size_t hstepA, hstepB;
    PG8_VOFFS(voffA, voffB, hstepA, hstepB, cs);
    const char* cA = cs.A; const char* cB = cs.B;
    PG8_STAGE(PG8_SB(0, 0), cB, voffB); PG8_STAGE(PG8_SB(0, 1), cB + hstepB, voffB); PG8_STAGE(PG8_SA(0, 0), cA, voffA); PG8_STAGE(PG8_SA(0, 1), cA + hstepA, voffA);
    if (wr == 1) PG8_BAR;
    PG8_WAIT_V(2); PG8_BAR;
    PG8_STAGE(PG8_SB(1, 0), cB + kstep, voffB); PG8_STAGE(PG8_SA(1, 0), cA + kstep, voffA); PG8_STAGE(PG8_SB(1, 1), cB + hstepB + kstep, voffB);
    PG8_WAIT_V(6); PG8_BAR;
    for (;;) {
        const bool has_next = S.next(ui + 1, nxt);
#pragma unroll 1
        for (int sgi = 0; sgi < NSEG; ++sgi) {
            const Seg ns = (sgi + 1 < NSEG) ? g.seg(cur, sgi + 1) : g.seg(has_next ? nxt : cur, 0);
            unsigned nvA[2], nvB[2]; size_t nhA, nhB;
            if constexpr (GemmT::UNIFORM) { nvA[0] = voffA[0]; nvA[1] = voffA[1]; nvB[0] = voffB[0]; nvB[1] = voffB[1]; nhA = hstepA; nhB = hstepB; }
            else PG8_VOFFS(nvA, nvB, nhA, nhB, ns);
            const int nt = cs.nt;
            for (int t = 0; t < nt; t += 2) {
                const bool last = (t == nt - 2);
                const char* a1 = cA + (size_t)(t + 1) * kstep;
                const char* a2 = last ? ns.A : cA + (size_t)(t + 2) * kstep; const char* b2 = last ? ns.B : cB + (size_t)(t + 2) * kstep;
                const char* a3 = a2 + kstep; const char* b3 = b2 + kstep;
                unsigned vA2[2], vB2[2];
#pragma unroll
                for (int i = 0; i < 2; ++i) { vA2[i] = last ? nvA[i] : voffA[i]; vB2[i] = last ? nvB[i] : voffB[i]; }
                const size_t hA2 = last ? nhA : hstepA, hB2 = last ? nhB : hstepB;
                PG8_LDB(B0, 0, 0); PG8_LDB(B1, 0, 1); PG8_SCHED; PG8_LDA(At, 0, 0); PG8_STAGE(PG8_SA(1, 1), a1 + hstepA, voffA);
                PG8_WAIT_V(8); PG8_WAIT_L(0); PG8_BAR; PG8_MMA(0, 0, At, B0); PG8_MMA(0, 1, At, B1); PG8_BAR; PG8_SCHED;
                PG8_LDA(At, 0, 1); PG8_STAGE(PG8_SB(0, 0), b2, vB2); PG8_STAGE(PG8_SB(0, 1), b2 + hB2, vB2); PG8_STAGE(PG8_SA(0, 0), a2, vA2);
                PG8_WAIT_V(8); PG8_WAIT_L(0); PG8_BAR; PG8_MMA(1, 0, At, B0); PG8_MMA(1, 1, At, B1); PG8_BAR; PG8_SCHED;
                PG8_LDB(B0, 1, 0); PG8_LDB(B1, 1, 1); PG8_SCHED; PG8_LDA(At, 1, 0); PG8_STAGE(PG8_SA(0, 1), a2 + hA2, vA2);
                PG8_WAIT_V(8); PG8_WAIT_L(0); PG8_BAR; PG8_MMA(0, 0, At, B0); PG8_MMA(0, 1, At, B1); PG8_BAR; PG8_SCHED;
                PG8_LDA(At, 1, 1); PG8_STAGE(PG8_SB(1, 0), b3, vB2); PG8_STAGE(PG8_SB(1, 1), b3 + hB2, vB2); PG8_STAGE(PG8_SA(1, 0), a3, vA2);
                PG8_WAIT_V(8); PG8_WAIT_L(0); PG8_BAR; PG8_MMA(1, 0, At, B0); PG8_MMA(1, 1, At, B1); PG8_BAR; PG8_SCHED;
            }
            if constexpr (NSEG > 1) { if (sgi + 1 < NSEG) E.mid(acc, cur, sgi, wr, wc, fr, fq); }
            cs = ns; cA = ns.A; cB = ns.B; hstepA = nhA; hstepB = nhB;
#pragma unroll
            for (int i = 0; i < 2; ++i) { voffA[i] = nvA[i]; voffB[i] = nvB[i]; }
        }
        if (wr == 0) PG8_BAR;
        if constexpr (GemmT::FP8) asm volatile("s_nop 15\n\ts_nop 15" ::: "memory");
        E(acc, cur, wr, wc, fr, fq);
        if (!has_next) break;
#pragma unroll
        for (int a = 0; a < 2; ++a)
#pragma unroll
            for (int b = 0; b < 2; ++b)
#pragma unroll
                for (int m = 0; m < 4; ++m)
#pragma unroll
                    for (int n = 0; n < 2; ++n) acc[a][b][m][n] = (f32x4){0.f, 0.f, 0.f, 0.f};
        cur = nxt; ++ui;
        if (wr == 1) PG8_BAR;
    }
    PG8_WAIT_V(0);
    PG8_BAR;
#undef PG8_SA
#undef PG8_SB
#undef PG8_STAGE
#undef PG8_LDA
#undef PG8_LDB
#undef PG8_MMA
#undef PG8_CAT
#undef PG8_WAIT_V
#undef PG8_WAIT_L
#undef PG8_BAR
#undef PG8_SCHED
#undef PG8_VOFFS
}
}

namespace att {
constexpr int SLOTB = 65536, K_OFF = 0, V_OFF = 32768;
__device__ __forceinline__ void glds16s(unsigned voff, const void* sbase, unsigned lds_dst) { unsigned keep;
    asm volatile("s_mov_b32 %0, m0\n\ts_mov_b32 m0, %3\n\ts_nop 0\n\tglobal_load_lds_dwordx4 %1, %2\n\ts_mov_b32 m0, %0" : "=&s"(keep) : "v"(voff), "s"(sbase), "s"(lds_dst) : "memory"); }
__device__ __forceinline__ void glds16s_nc(unsigned voff, const void* sbase, unsigned lds_dst) { unsigned keep;
    asm volatile("s_mov_b32 %0, m0\n\ts_mov_b32 m0, %3\n\ts_nop 0\n\tglobal_load_lds_dwordx4 %1, %2\n\ts_mov_b32 m0, %0" : "=&s"(keep) : "v"(voff), "s"(sbase), "s"(lds_dst)); }
typedef short v4i16_t __attribute__((ext_vector_type(4)));
__device__ __forceinline__ s16x4 vtr(const LAS unsigned char* p) { return __builtin_bit_cast(s16x4, __builtin_amdgcn_ds_read_tr16_b64_v4i16((LAS v4i16_t*)p)); }
#define ATT_WAIT_BAR() asm volatile("s_waitcnt vmcnt(0) lgkmcnt(0)\n\ts_barrier" ::: "memory")

#define ATT_SB() __builtin_amdgcn_sched_barrier(0)
__device__ __forceinline__ void rowbuf_put(LAS unsigned char* buf, int fr, int fq, int qh, int db, u32x2 w) {
    const int row = 16 * qh + fr; *(LAS u32x2*)(buf + row * 512 + (((2 * db + (fq >> 1)) ^ (row & 15)) << 4) + (fq & 1) * 8) = w; }
template <int NROWS>
__device__ __forceinline__ void rowbuf_store(const LAS unsigned char* buf, int lane, bf16_t* gdst, int pitch) {
    asm volatile("s_waitcnt lgkmcnt(0)" ::: "memory");
    bf16_t* dst = gdst + (size_t)(lane >> 5) * pitch + (lane & 31) * 8;
#pragma unroll
    for (int i = 0; i < NROWS / 2; ++i) { const int row = 2 * i + (lane >> 5);
        const u32x4 v = *(const LAS u32x4*)(buf + row * 512 + (((lane & 31) ^ (row & 15)) << 4)); *(u32x4*)(dst + (size_t)(2 * i) * pitch) = v; }
}

__device__ __forceinline__ void attn_core16(f32x4 (&O)[16][2], float (&lq)[2], const bf16_t* Qw, int q_pitch, const bf16_t* Kh, const bf16_t* Vh, int kv_pitch,
                                            int NT, int nt_act, int kch0, float negb, LAS unsigned char* ring, int wid) {
    int lane = (int)__builtin_amdgcn_mbcnt_hi(~0u, __builtin_amdgcn_mbcnt_lo(~0u, 0u)); asm volatile("" : "+v"(lane));
    const int fr = lane & 15, fq = lane >> 4;
    const unsigned lds0 = (unsigned)(uintptr_t)ring;
    const int prow = lane >> 3;
    const int kq = (lane & 7) ^ ((4 * (wid & 1) + (lane >> 4)) & 7);
    const int vq = (lane & 7) ^ (((prow >> 1) & 3) << 1);
    const unsigned koff = (unsigned)((8 * wid + prow) * kv_pitch + kq * 8) * 2u, voff = (unsigned)((8 * wid + prow) * kv_pitch + vq * 8) * 2u;
#define A16_DMA_K(t, slot) do { const bf16_t* ks_ = Kh + (size_t)(t) * 64 * kv_pitch; const unsigned kd_ = (unsigned)__builtin_amdgcn_readfirstlane(lds0 + (slot) * SLOTB + K_OFF + wid * 4096); \
        _Pragma("unroll") for (int j_ = 0; j_ < 4; ++j_) glds16s(koff, ks_ + j_ * 64, kd_ + j_ * 1024); } while (0)
#define A16_DMA_V(t, slot) do { const bf16_t* vs_ = Vh + (size_t)(t) * 64 * kv_pitch; const unsigned vd_ = (unsigned)__builtin_amdgcn_readfirstlane(lds0 + (slot) * SLOTB + V_OFF + wid * 4096); \
        _Pragma("unroll") for (int j_ = 0; j_ < 4; ++j_) glds16s(voff, vs_ + j_ * 64, vd_ + j_ * 1024); } while (0)
#define A16_DMA_K1(t, slot, j) glds16s_nc(koff, Kh + (size_t)(t) * 64 * kv_pitch + (j) * 64, (unsigned)__builtin_amdgcn_readfirstlane(lds0 + (slot) * SLOTB + K_OFF + wid * 4096 + (j) * 1024))
#define A16_DMA_V1(t, slot, j) glds16s_nc(voff, Vh + (size_t)(t) * 64 * kv_pitch + (j) * 64, (unsigned)__builtin_amdgcn_readfirstlane(lds0 + (slot) * SLOTB + V_OFF + wid * 4096 + (j) * 1024))
    A16_DMA_K(0, 0); A16_DMA_V(0, 0);
    if (NT > 1) A16_DMA_K(1, 1);
    bf16x8 qr[2][4];
    const bf16_t* qp = Qw + (size_t)fr * q_pitch + fq * 8;
#pragma unroll
    for (int qh = 0; qh < 2; ++qh)
#pragma unroll
        for (int d = 0; d < 4; ++d) qr[qh][d] = *(const bf16x8*)(qp + (size_t)(qh * 16) * q_pitch + d * 32);
    const f32x4 z4 = {0.f, 0.f, 0.f, 0.f};
#pragma unroll
    for (int db = 0; db < 16; ++db) { O[db][0] = z4; O[db][1] = z4; }
    float l0 = 0.f, l1 = 0.f;
    const int ksw = (fr >> 1) & 7;
    const LAS unsigned char* kb0 = ring + K_OFF + (kch0 >> 3) * 1024 + (fr >> 3) * 4096 + (fr & 7) * 128;
    const LAS unsigned char* kbp[2] = {kb0 + ((0 + fq) ^ ksw) * 16, kb0 + ((4 + fq) ^ ksw) * 16};
    const int vsw = ((2 * (fq & 1) + (fr >> 3)) & 3) << 1;
    const LAS unsigned char* vb0 = ring + V_OFF + (fq >> 1) * 4096 + (4 * (fq & 1) + (fr >> 2)) * 128 + ((fr & 3) >> 1) * 16 + (fr & 1) * 8;
    const LAS unsigned char* vbp[4] = {vb0 + ((0 ^ vsw) << 4), vb0 + ((2 ^ vsw) << 4), vb0 + ((4 ^ vsw) << 4), vb0 + ((6 ^ vsw) << 4)};
    f32x4 S[4][2]; u32x4 pw[2][2];
    f32x4 nb4 = {negb, negb, negb, negb}; asm volatile("" : "+v"(nb4));
#define A16_KF(kb, ds) (*(const LAS bf16x8*)(kbp[(ds) & 1] + so_ + (kb) * 8192 + ((ds) >> 1) * 1024))
#define A16_QK(tt, DMAI, td) do { const int so_ = ((tt) & 1) * SLOTB; const int tk_ = ((td) + 2 < NT) ? (td) + 2 : NT - 1, tv_ = ((td) + 1 < NT) ? (td) + 1 : NT - 1; (void)tk_; (void)tv_; \
        bf16x8 kf_[3]; kf_[0] = A16_KF(0, 0); kf_[1] = A16_KF(1, 0); \
        ATT_SB(); \
        _Pragma("unroll") for (int g_ = 0; g_ < 16; ++g_) { const int ds_ = g_ >> 2, kb_ = g_ & 3; \
            if (g_ + 2 < 16) kf_[(g_ + 2) % 3] = A16_KF((g_ + 2) & 3, (g_ + 2) >> 2); \
            S[kb_][0] = __builtin_amdgcn_mfma_f32_16x16x32_bf16(kf_[g_ % 3], qr[0][ds_], (ds_ == 0) ? nb4 : S[kb_][0], 0, 0, 0); \
            S[kb_][1] = __builtin_amdgcn_mfma_f32_16x16x32_bf16(kf_[g_ % 3], qr[1][ds_], (ds_ == 0) ? nb4 : S[kb_][1], 0, 0, 0); \
            if ((DMAI) && g_ < 8) { if (g_ < 4) A16_DMA_K1(tk_, (td) & 1, g_); else A16_DMA_V1(tv_, ((td) + 1) & 1, g_ - 4); } \
            ATT_SB(); } } while (0)
#define A16_EL(i) S[(i) >> 3][((i) >> 2) & 1][(i) & 3]
#define A16_PACK() do { _Pragma("unroll") for (int p_ = 0; p_ < 2; ++p_) _Pragma("unroll") for (int h_ = 0; h_ < 2; ++h_) \
        pw[p_][h_] = (u32x4){pk2(S[2 * p_][h_][0], S[2 * p_][h_][1]), pk2(S[2 * p_][h_][2], S[2 * p_][h_][3]), pk2(S[2 * p_ + 1][h_][0], S[2 * p_ + 1][h_][1]), pk2(S[2 * p_ + 1][h_][2], S[2 * p_ + 1][h_][3])}; } while (0)
    ATT_WAIT_BAR();
#pragma unroll
    for (int qh = 0; qh < 2; ++qh)
#pragma unroll
        for (int d = 0; d < 4; ++d) asm volatile("" : "+v"(qr[qh][d]));
    {
        A16_QK(0, 0, 0);
        float s0 = 0.f, s1 = 0.f;
#pragma unroll
        for (int i = 0; i < 32; ++i) { A16_EL(i) = __builtin_amdgcn_exp2f(A16_EL(i)); if ((i >> 2) & 1) s1 += A16_EL(i); else s0 += A16_EL(i); }
        l0 += s0; l1 += s1;
        A16_PACK();
    }
#pragma unroll 1
    for (int t = 0; t < NT; ++t) {
        ATT_WAIT_BAR();
        if (t < nt_act) {
            const bool more = (t + 1 < nt_act);
            const int vso = (t & 1) * SLOTB;
            s16x4 vv[3][2];
#define A16_VLD(v, g) do { const LAS unsigned char* a_ = vbp[(g) & 3] + vso + ((g) >> 4) * 16384 + (((g) & 15) >> 2) * 1024; v[0] = vtr(a_); v[1] = vtr(a_ + 8192); } while (0)
#define A16_VF(v) (bf16x8){v[0][0], v[0][1], v[0][2], v[0][3], v[1][0], v[1][1], v[1][2], v[1][3]}
            A16_VLD(vv[0], 0);
            ATT_SB();
            A16_QK(t + 1, 1, t);
            ATT_SB();
            A16_VLD(vv[1], 1);
            float s0 = 0.f, s1 = 0.f;
#define A16_GAP(i) do { A16_EL(i) = __builtin_amdgcn_exp2f(A16_EL(i)); \
                if ((i) > 0) { if ((((i) - 1) >> 2) & 1) s1 += A16_EL((i) - 1); else s0 += A16_EL((i) - 1); } asm volatile("" : "+v"(s0), "+v"(s1)); } while (0)
#pragma unroll
            for (int g = 0; g < 32; ++g) {
                if (g + 2 < 32) A16_VLD(vv[(g + 2) % 3], g + 2);
                ATT_SB();
                O[g & 15][0] = __builtin_amdgcn_mfma_f32_16x16x32_bf16(A16_VF(vv[g % 3]), __builtin_bit_cast(bf16x8, pw[g >> 4][0]), O[g & 15][0], 0, 0, 0);
                O[g & 15][1] = __builtin_amdgcn_mfma_f32_16x16x32_bf16(A16_VF(vv[g % 3]), __builtin_bit_cast(bf16x8, pw[g >> 4][1]), O[g & 15][1], 0, 0, 0);
                A16_GAP(g);
                ATT_SB();
            }
#undef A16_VLD
#undef A16_VF
#undef A16_GAP
            l0 += more ? s0 : 0.f; l1 += more ? (s1 + A16_EL(31)) : 0.f;
            A16_PACK();
        }
    }
    ATT_WAIT_BAR();
    l0 += sx<16>(l0); l1 += sx<16>(l1);
    lq[0] = sum32x(l0); lq[1] = sum32x(l1);
#undef A16_DMA_K
#undef A16_DMA_V
#undef A16_DMA_K1
#undef A16_DMA_V1
#undef A16_QK
#undef A16_KF
#undef A16_EL
#undef A16_PACK
}

__device__ __forceinline__ void mem_attn_core16(const bf16_t* Qw, int q_pitch, const bf16_t* Kh, const bf16_t* Vh, int kv_pitch, float negb, LAS unsigned char* ring, int wid, bf16_t* Yw, int y_pitch) {
    int lane = (int)__builtin_amdgcn_mbcnt_hi(~0u, __builtin_amdgcn_mbcnt_lo(~0u, 0u)); asm volatile("" : "+v"(lane));
    const int fr = lane & 15, fq = lane >> 4;
    const unsigned lds0 = (unsigned)(uintptr_t)ring;
    const int prow = lane >> 3;
    const int kq = (lane & 7) ^ ((4 * (wid & 1) + (lane >> 4)) & 7);
    const int vq = (lane & 7) ^ (((prow >> 1) & 3) << 1);
    const unsigned koff = (unsigned)((8 * wid + prow) * kv_pitch + kq * 8) * 2u, voff = (unsigned)((8 * wid + prow) * kv_pitch + vq * 8) * 2u;
    const unsigned dst0 = (unsigned)__builtin_amdgcn_readfirstlane(lds0 + wid * 4096);
#pragma unroll
    for (int t = 0; t < 4; ++t)
#pragma unroll
        for (int j = 0; j < 4; ++j) glds16s(koff, Kh + (size_t)t * 64 * kv_pitch + j * 64, dst0 + t * 32768 + j * 1024);
    const bf16_t* qp = Qw + (size_t)fr * q_pitch + fq * 8;
    const int ksw = (fr >> 1) & 7;
    const LAS unsigned char* kb0 = ring + (fr >> 3) * 4096 + (fr & 7) * 128;
    const LAS unsigned char* kbp[2] = {kb0 + ((0 + fq) ^ ksw) * 16, kb0 + ((4 + fq) ^ ksw) * 16};
    asm volatile("s_waitcnt vmcnt(0) lgkmcnt(0)\n\ts_barrier" ::: "memory");
    f32x4 S[4][4][2];
    const f32x4 z4 = {0.f, 0.f, 0.f, 0.f};
#pragma unroll
    for (int hf = 0; hf < 2; ++hf) {
        bf16x8 qr[2][4];
#pragma unroll
        for (int qh = 0; qh < 2; ++qh)
#pragma unroll
            for (int d = 0; d < 4; ++d) qr[qh][d] = *(const bf16x8*)(qp + (size_t)(qh * 16) * q_pitch + (hf * 4 + d) * 32);
#pragma unroll
        for (int t = 0; t < 4; ++t)
#pragma unroll
            for (int kb = 0; kb < 4; ++kb)
#pragma unroll
                for (int d = 0; d < 4; ++d) { const int ds = hf * 4 + d;
                    const bf16x8 kf = *(const LAS bf16x8*)(kbp[ds & 1] + t * 32768 + kb * 8192 + (ds >> 1) * 1024);
#pragma unroll
                    for (int qh = 0; qh < 2; ++qh) S[t][kb][qh] = __builtin_amdgcn_mfma_f32_16x16x32_bf16(kf, qr[qh][d], (ds == 0) ? z4 : S[t][kb][qh], 0, 0, 0);
                    if (d & 1) __builtin_amdgcn_sched_barrier(0); }
    }
    asm volatile("s_waitcnt lgkmcnt(0)\n\ts_barrier" ::: "memory");
#pragma unroll
    for (int t = 0; t < 4; ++t)
#pragma unroll
        for (int j = 0; j < 4; ++j) glds16s(voff, Vh + (size_t)t * 64 * kv_pitch + j * 64, dst0 + t * 32768 + j * 1024);
    float l[2] = {0.f, 0.f}; u32x4 pw[4][2][2];
#pragma unroll
    for (int t = 0; t < 4; ++t)
#pragma unroll
        for (int p = 0; p < 2; ++p)
#pragma unroll
            for (int qh = 0; qh < 2; ++qh) { f32x4 a = S[t][2 * p][qh], b = S[t][2 * p + 1][qh];
#pragma unroll
                for (int e = 0; e < 4; ++e) { a[e] = __builtin_amdgcn_exp2f(a[e] + negb); b[e] = __builtin_amdgcn_exp2f(b[e] + negb); }
                l[qh] += ((a[0] + a[1]) + (a[2] + a[3])) + ((b[0] + b[1]) + (b[2] + b[3])); asm volatile("" : "+v"(l[qh]));
                pw[t][p][qh] = (u32x4){pk2(a[0], a[1]), pk2(a[2], a[3]), pk2(b[0], b[1]), pk2(b[2], b[3])};
                __builtin_amdgcn_sched_barrier(0); }
    const int vsw = ((2 * (fq & 1) + (fr >> 3)) & 3) << 1;
    const LAS unsigned char* vb0 = ring + (fq >> 1) * 4096 + (4 * (fq & 1) + (fr >> 2)) * 128 + ((fr & 3) >> 1) * 16 + (fr & 1) * 8;
    const LAS unsigned char* vbp[4] = {vb0 + ((0 ^ vsw) << 4), vb0 + ((2 ^ vsw) << 4), vb0 + ((4 ^ vsw) << 4), vb0 + ((6 ^ vsw) << 4)};
    asm volatile("s_waitcnt vmcnt(0) lgkmcnt(0)\n\ts_barrier" ::: "memory");
    f32x4 O[16][2];
#pragma unroll
    for (int t = 0; t < 4; ++t)
#pragma unroll
        for (int p = 0; p < 2; ++p)
#pragma unroll
            for (int db = 0; db < 16; ++db) {
                const LAS unsigned char* va = vbp[db & 3] + t * 32768 + p * 16384 + (db >> 2) * 1024;
                const s16x4 lo = vtr(va), hh = vtr(va + 8192);
                const bf16x8 vf = (bf16x8){lo[0], lo[1], lo[2], lo[3], hh[0], hh[1], hh[2], hh[3]};
#pragma unroll
                for (int qh = 0; qh < 2; ++qh) O[db][qh] = __builtin_amdgcn_mfma_f32_16x16x32_bf16(vf, __builtin_bit_cast(bf16x8, pw[t][p][qh]), (t == 0 && p == 0) ? z4 : O[db][qh], 0, 0, 0);
                if (db & 1) __builtin_amdgcn_sched_barrier(0); }
    asm volatile("s_waitcnt lgkmcnt(0)\n\ts_barrier" ::: "memory");
    LAS unsigned char* rb = ring + wid * 16384;
#pragma unroll
    for (int qh = 0; qh < 2; ++qh) { float ls = l[qh]; ls += sx<16>(ls); ls = sum32x(ls);
        const float inv = __builtin_amdgcn_rcpf(ls);
#pragma unroll
        for (int db = 0; db < 16; ++db) { const f32x4 v = O[db][qh] * inv; u32x2 w; w.x = pk2(v[0], v[1]); w.y = pk2(v[2], v[3]); rowbuf_put(rb, fr, fq, qh, db, w); } }
    rowbuf_store<32>(rb, lane, Yw, y_pitch);
}
}

#define XB_TMO      128
#define XB_XCNT(j)  (256  + 64 * (j))
#define XB_XSUB(j)  (1280 + 64 * (j))
#define XB_XGEN(j)  (2304 + 64 * (j))
#define XB_TOP      3328
#define XB_TOPGEN   3392
#define XCD_BAR_WORDS 3456
#define XB_SPIN_CAP (1u << 22)

__device__ __forceinline__ unsigned xb_ld(unsigned* p)              { return __hip_atomic_load(p, __ATOMIC_RELAXED, __HIP_MEMORY_SCOPE_AGENT); }
__device__ __forceinline__ unsigned xb_add(unsigned* p, unsigned v) { return __hip_atomic_fetch_add(p, v, __ATOMIC_RELAXED, __HIP_MEMORY_SCOPE_AGENT); }
__device__ __forceinline__ unsigned xb_xcc_id() { return (unsigned)__builtin_amdgcn_s_getreg((3 << 11) | 20) & 0xFu; }
#define XB_SPIN(cond, bar) do { unsigned _sp = 0; while (cond) { __builtin_amdgcn_s_sleep(1); \
    if ((++_sp & 255u) == 0u) { if (xb_ld(&(bar)[XB_TMO])) break; if (_sp > XB_SPIN_CAP) { atomicAdd(&(bar)[XB_TMO], 1u); break; } } } } while (0)

struct XcdBarrier { unsigned* bar; unsigned x; volatile LAS unsigned* st; };

__device__ __forceinline__ XcdBarrier xcd_barrier_post(unsigned* bar, volatile LAS unsigned* st) {
    XcdBarrier b; b.bar = bar; b.x = xb_xcc_id(); b.st = st;
    if (threadIdx.x == 0) (void)xb_add(&bar[XB_XCNT(b.x)], 1u);
    return b;
}
__device__ __forceinline__ bool xb_leader(int wave) { return wave == 0 && __builtin_amdgcn_mbcnt_hi(~0u, __builtin_amdgcn_mbcnt_lo(~0u, 0u)) == 0u; }
__device__ __forceinline__ void xcd_barrier_complete(unsigned* bar, unsigned x, unsigned& nloc, unsigned& nx) {
    const unsigned G = gridDim.x * gridDim.y * gridDim.z;
    unsigned sum, cnt, mine, sp = 0u;
    for (;;) {
        sum = 0u; cnt = 0u; mine = 0u;
#pragma unroll
        for (unsigned j = 0; j < 16; ++j) { const unsigned c = xb_ld(&bar[XB_XCNT(j)]); sum += c; cnt += (c > 0u) ? 1u : 0u; mine = (j == x) ? c : mine; }
        if (sum == G) break;
        __builtin_amdgcn_s_sleep(1);
        if ((++sp & 255u) == 0u) { if (xb_ld(&bar[XB_TMO])) break; if (sp > XB_SPIN_CAP) { atomicAdd(&bar[XB_TMO], 1u); break; } }
    }
    nloc = mine > 0u ? mine : 1u; nx = cnt > 0u ? cnt : 1u;
}
__device__ __forceinline__ void xcd_barrier(const XcdBarrier& b, const int wave) {
    asm volatile("s_waitcnt vmcnt(0)" ::: "memory");
    __syncthreads();
    if (xb_leader(wave)) {
        unsigned* bar = b.bar;
        __builtin_amdgcn_s_waitcnt(0);
        unsigned nloc = b.st[0], nx = b.st[1];
        if (nloc == 0u) { xcd_barrier_complete(bar, b.x, nloc, nx); b.st[0] = nloc; b.st[1] = nx; }
        const unsigned old = xb_add(&bar[XB_XSUB(b.x)], 1u);
        const unsigned gen = old / nloc;
        if (old + 1u == (gen + 1u) * nloc) {
            __builtin_amdgcn_fence(__ATOMIC_RELEASE, "agent");
            asm volatile("s_waitcnt vmcnt(0)" ::: "memory");
            const unsigned og = xb_add(&bar[XB_TOP], 1u);
            const unsigned tg = og / nx;
            if (og + 1u == (tg + 1u) * nx) xb_add(&bar[XB_TOPGEN], 1u);
            else XB_SPIN(xb_ld(&bar[XB_TOPGEN]) == tg, bar);
            __builtin_amdgcn_fence(__ATOMIC_ACQUIRE, "agent");
            xb_add(&bar[XB_XGEN(b.x)], 1u);
            asm volatile("s_waitcnt vmcnt(0)" ::: "memory");
        } else {
            XB_SPIN(xb_ld(&bar[XB_XGEN(b.x)]) == gen, bar);
            __builtin_amdgcn_fence(__ATOMIC_ACQUIRE, "agent");
            asm volatile("s_waitcnt vmcnt(0)" ::: "memory");
        }
    }
    __syncthreads();
}

__device__ __forceinline__ void transpose_item(const float* W, int N, int k0, int nsrc0, bf16_t* WT, int ldt, int ndst0, LAS float* scr, int lane, const float* kscale = nullptr) {
    float wv[32];
#pragma unroll
    for (int i = 0; i < 32; ++i) wv[i] = __builtin_nontemporal_load(&W[(size_t)(k0 + 2 * i + (lane >> 5)) * N + nsrc0 + (lane & 31)]);
#pragma unroll
    for (int i = 0; i < 32; ++i) { const int kk = 2 * i + (lane >> 5); const float sc = kscale ? kscale[k0 + kk] : 1.0f; scr[kk * 33 + (lane & 31)] = wv[i] * sc; }
    LDS_WAIT(); asm volatile("" ::: "memory");
    const int c = lane & 7;
#pragma unroll
    for (int j = 0; j < 4; ++j) { const int n = (lane >> 3) + 8 * j; const LAS float* s = scr + (8 * c) * 33 + n;
        u32x4 o; o.x = pk2(s[0 * 33], s[1 * 33]); o.y = pk2(s[2 * 33], s[3 * 33]); o.z = pk2(s[4 * 33], s[5 * 33]); o.w = pk2(s[6 * 33], s[7 * 33]);
        *(GAS u32x4*)(WT + (size_t)(ndst0 + n) * ldt + k0 + 8 * c) = o; }
    LDS_WAIT(); asm volatile("" ::: "memory");
}
__device__ __forceinline__ void transpose_item_fp8(const float* W, int N, int k0, int nsrc0, unsigned char* WT8, int ldt, int ndst0, LAS float* scr, int lane, float scale) {
    float wv[32];
#pragma unroll
    for (int i = 0; i < 32; ++i) wv[i] = __builtin_nontemporal_load(&W[(size_t)(k0 + 2 * i + (lane >> 5)) * N + nsrc0 + (lane & 31)]);
#pragma unroll
    for (int i = 0; i < 32; ++i) { const int kk = 2 * i + (lane >> 5); scr[kk * 33 + (lane & 31)] = wv[i] * scale; }
    LDS_WAIT(); asm volatile("" ::: "memory");
    const int c = lane & 7;
#pragma unroll
    for (int j = 0; j < 4; ++j) { const int n = (lane >> 3) + 8 * j; const LAS float* s = scr + (8 * c) * 33 + n;
        u32x2 o; o.x = pk4_fp8(s[0 * 33], s[1 * 33], s[2 * 33], s[3 * 33]); o.y = pk4_fp8(s[4 * 33], s[5 * 33], s[6 * 33], s[7 * 33]);
        *(GAS u32x2*)(WT8 + (size_t)(ndst0 + n) * ldt + k0 + 8 * c) = o; }
    LDS_WAIT(); asm volatile("" ::: "memory");
}
__device__ __forceinline__ void tr_plain(const float* W, int K, int N, bf16_t* WT, LAS float* scr, int r, int lane) {
    const int nblk = N / 32, kb = r / nblk, nb = r % nblk;
    transpose_item(W, N, 64 * kb, 32 * nb, WT, K, 32 * nb, scr, lane);
}
__device__ __forceinline__ void rms_row_4096(const float* xrow, const float* g, bf16_t* orow, int lane, unsigned char* qrow = nullptr, float* rs_out = nullptr) {
    const GAS f32x4* xr = (const GAS f32x4*)xrow + lane; const GAS f32x4* gr = (const GAS f32x4*)g + lane;
    f32x4 v[16]; float s = 0.f;
#pragma unroll
    for (int j = 0; j < 16; ++j) { v[j] = __builtin_nontemporal_load(xr + 64 * j); s += (v[j].x * v[j].x + v[j].y * v[j].y) + (v[j].z * v[j].z + v[j].w * v[j].w); }
    const float rstd = 1.f / sqrtf(wave_sum(s) * (1.f / 4096.f) + EPS);
    if (rs_out != nullptr && lane == 0) *rs_out = rstd;
    GAS u32x2* o8 = (GAS u32x2*)orow + lane;
#pragma unroll
    for (int j = 0; j < 16; ++j) { const f32x4 gg = gr[64 * j]; const float y0 = v[j].x * rstd * gg.x, y1 = v[j].y * rstd * gg.y, y2 = v[j].z * rstd * gg.z, y3 = v[j].w * rstd * gg.w;
        u32x2 w; if (rs_out != nullptr) { w.x = pk2(v[j].x, v[j].y); w.y = pk2(v[j].z, v[j].w); } else { w.x = pk2(y0, y1); w.y = pk2(y2, y3); }
        o8[64 * j] = w;
        if (qrow) ((GAS unsigned*)qrow + lane)[64 * j] = pk4_fp8(y0, y1, y2, y3); }
}
__constant__ float ROPE_INV2PI[16] = {1.5915494309e-01f, 7.0086521588e-02f, 3.0863763405e-02f, 1.3591370636e-02f, 5.9851857127e-03f, 2.6356758987e-03f, 1.1606636412e-03f, 5.1111750454e-04f,
                                      2.2507907904e-04f, 9.9117309369e-05f, 4.3647952793e-05f, 1.9221100685e-05f, 8.4643308082e-06f, 3.7274086019e-06f, 1.6414262628e-06f, 7.2282930688e-07f};
template <int W>
__device__ __forceinline__ void pool_prep_seg(const bf16_t* src, bf16_t* dst, int t0) {
    u32x4 wv[W - 1 + 16];
#pragma unroll
    for (int k = 0; k < W - 1 + 16; ++k) { const int rel = k - (W - 1); wv[k] = (rel >= 0 || t0 > 0) ? *(const u32x4*)(src + (ptrdiff_t)rel * 1024) : (u32x4){0u, 0u, 0u, 0u}; }
    float sm[8];
#pragma unroll
    for (int e = 0; e < 8; ++e) sm[e] = 0.f;
#pragma unroll
    for (int k = 0; k < W - 1; ++k) { float f[8]; unpack8(wv[k], f);
#pragma unroll
        for (int e = 0; e < 8; ++e) sm[e] += f[e]; }
#pragma unroll
    for (int j = 0; j < 16; ++j) { float cur[8], f[8]; unpack8(wv[W - 1 + j], cur);
#pragma unroll
        for (int e = 0; e < 8; ++e) sm[e] += cur[e];
        const int n = (t0 > 0 || j + 1 >= W) ? W : j + 1; const float inv = 1.0f / (float)n;
        u32x4 o; o.x = pk2(sm[0] * inv - cur[0], sm[1] * inv - cur[1]); o.y = pk2(sm[2] * inv - cur[2], sm[3] * inv - cur[3]);
        o.z = pk2(sm[4] * inv - cur[4], sm[5] * inv - cur[5]); o.w = pk2(sm[6] * inv - cur[6], sm[7] * inv - cur[7]);
        *(u32x4*)(dst + (size_t)j * 1024) = o;
        unpack8(wv[j], f);
#pragma unroll
        for (int e = 0; e < 8; ++e) sm[e] -= f[e]; }
}

struct Args { const float* in[26]; float* out; unsigned char* ws; };

__global__ void __launch_bounds__(NWAVES * 64, 2) mk_fwd(Args args) {
    extern __shared__ __attribute__((aligned(16))) unsigned char lds_raw[];
    LAS unsigned char* lds = (LAS unsigned char*)lds_raw;
    volatile LAS unsigned* MISC = (volatile LAS unsigned*)(lds + MISC_OFF);
    const int wave = __builtin_amdgcn_readfirstlane(threadIdx.x >> 6);
#define PHASE_IDS() int lane = (int)__builtin_amdgcn_mbcnt_hi(~0u, __builtin_amdgcn_mbcnt_lo(~0u, 0u)); asm volatile("" : "+v"(lane)); const int tid = wave * 64 + lane; const int gw = vcu * NWAVES + wave, NGW = G * NWAVES; (void)tid; (void)gw; (void)NGW
    const int G = gridDim.x; const int bx = blockIdx.x; const int vcu = (G % 8 == 0) ? (bx % 8) * (G / 8) + bx / 8 : bx;
    unsigned char* ws = args.ws;
    unsigned* ctl = (unsigned*)(ws + WS_CTL);
    const float* x = args.in[0]; const float* mem = args.in[1]; const float* g_attn = args.in[2]; const float* w_in = args.in[3];
    const float* g_qa = args.in[4]; const float* g_ka = args.in[5]; const float* lam_q1 = args.in[6]; const float* lam_k1 = args.in[7];
    const float* lam_q2 = args.in[8]; const float* lam_k2 = args.in[9]; const float* g_subln = args.in[10]; const float* w_pool = args.in[11];
    const float* pool_scale = args.in[12]; const float* g_mem = args.in[13]; const float* w_mkv = args.in[14]; const float* g_qm = args.in[15];
    const float* g_km = args.in[16]; const float* w_a = args.in[17]; const float* w_b = args.in[18]; const float* w_c = args.in[19];
    const float* w_o = args.in[20]; const float* g_ffn = args.in[21]; const float* w_up = args.in[22]; const float* conv_w = args.in[23];
    const float* conv_b = args.in[24]; const float* w_down = args.in[25];
    float* out = args.out;
    unsigned char* WG8 = ws + WS_WG8; unsigned char* H8 = (unsigned char*)out + DO_H8;
    bf16_t* W_UP = (bf16_t*)(ws + WS_WUP); bf16_t* W_DOWN = (bf16_t*)(ws + WS_WDOWN); bf16_t* W_IN = (bf16_t*)(ws + WS_WIN);
    bf16_t* W_A = (bf16_t*)(ws + WS_WA); bf16_t* W_B = (bf16_t*)(ws + WS_WB); bf16_t* W_C = (bf16_t*)(ws + WS_WC); bf16_t* W_O = (bf16_t*)(ws + WS_WO);
    bf16_t* W_MKV = (bf16_t*)(ws + WS_WMKV);
    bf16_t* KVM = (bf16_t*)(ws + WS_KVM); bf16_t* HM = (bf16_t*)(ws + WS_HM);
    bf16_t* QA = (bf16_t*)(ws + WS_QA); bf16_t* KA = (bf16_t*)(ws + WS_KA); bf16_t* VA = (bf16_t*)(ws + WS_VA);
    bf16_t* UPB = (bf16_t*)(ws + WS_UP); bf16_t* QM = (bf16_t*)(ws + WS_QM); unsigned char* GL = ws + WS_GL; bf16_t* YP = (bf16_t*)(ws + WS_YP);
    bf16_t* MERGED = (bf16_t*)(ws + WS_MERGED); bf16_t* X1B = (bf16_t*)(ws + WS_X1B); bf16_t* ACT = (bf16_t*)(ws + WS_ACT); float* SSQ = (float*)(ws + WS_SSQ); float* HALO = (float*)(ws + WS_HALO);
    bf16_t* XB = (bf16_t*)out; float* RS1 = (float*)(ws + WS_RS1); bf16_t* YA = (bf16_t*)((unsigned char*)out + DO_YA); bf16_t* YC = (bf16_t*)((unsigned char*)out + DO_YC);

    for (int u = threadIdx.x; u < (LDS_BYTES - LDSCTL_OFF) / 4; u += NWAVES * 64) ((LAS unsigned*)(lds + LDSCTL_OFF))[u] = 0u;
    __syncthreads();
    XcdBarrier bar = xcd_barrier_post(ctl + CW_BAR, MISC + 8);

    {
        PHASE_IDS();
        LAS float* scr = (LAS float*)(lds + RING_OFF + wave * 16384);
        for (int it = gw; it < 64 * 64; it += NGW) tr_plain(w_mkv, 4096, 2048, W_MKV, scr, it, lane);
        for (int m = gw; m < MROWS; m += NGW) rms_row_4096(mem + (size_t)m * DMODEL, g_mem, HM + (size_t)m * DMODEL, lane);
    }
    constexpr int MKV_CUS = 16;
    const bool p0_split = (G > 2 * MKV_CUS);
    if (p0_split) {
        asm volatile("s_waitcnt vmcnt(0)" ::: "memory");
        __syncthreads();
        if (xb_leader(wave)) { __builtin_amdgcn_fence(__ATOMIC_RELEASE, "agent"); asm volatile("s_waitcnt vmcnt(0)" ::: "memory"); (void)xb_add(ctl + CW_P0A, 1u); }
    } else xcd_barrier(bar, wave);
    if (vcu < MKV_CUS && p0_split) {
        if (xb_leader(wave)) { XB_SPIN(xb_ld(ctl + CW_P0A) != (unsigned)G, ctl + CW_BAR); __builtin_amdgcn_fence(__ATOMIC_ACQUIRE, "agent"); asm volatile("s_waitcnt vmcnt(0)" ::: "memory"); }
        __syncthreads();
        struct OneUnit { int id; __device__ __forceinline__ bool next(int i, pg8::Unit& u) const { if (i != 0) return false; u.pm = id >> 3; u.pn = id & 7; return true; } };
        pg8::Gemm1 g{HM, W_MKV, DMODEL, DMODEL, DMODEL, 0}; OneUnit S{vcu};
        pg8::EpiKvm E{KVM, g_km, (LAS float*)(lds + XCH_OFF)};
        pg8::gemm_phase<pg8::EpiKvm, OneUnit, pg8::Gemm1>(lds + RING_OFF, g, S, E, wave);
        {
            PHASE_IDS();
            LAS float* scr = (LAS float*)(lds + RING_OFF + wave * 16384);
            for (int it = wave; it < 128; it += NWAVES) { const int kb = it >> 3, nb = it & 7;
                transpose_item(w_b, 4096, 64 * kb, 256 * vcu + 32 * nb, W_B, 1024, 256 * vcu + 32 * nb, scr, lane, pool_scale); }
            bf16_t* WPc = (bf16_t*)(ws + WS_WPF) + (size_t)vcu * (1024 * 256);
#pragma unroll 1
            for (int r0 = wave * 128; r0 < wave * 128 + 128; r0 += 16) { f32x4 v[16];
#pragma unroll
                for (int j = 0; j < 16; ++j) v[j] = __builtin_nontemporal_load((const f32x4*)(w_pool + (size_t)(r0 + j) * 256 + 4 * lane));
#pragma unroll
                for (int j = 0; j < 16; ++j) { u32x2 w; w.x = pk2(v[j][0], v[j][1]); w.y = pk2(v[j][2], v[j][3]); *(u32x2*)(WPc + (size_t)(r0 + j) * 256 + 4 * lane) = w; } }
            asm volatile("s_waitcnt vmcnt(0)" ::: "memory");
            __syncthreads();
            if (xb_leader(wave)) { __builtin_amdgcn_fence(__ATOMIC_ACQ_REL, "agent"); asm volatile("s_waitcnt vmcnt(0)" ::: "memory"); }
            __syncthreads();
            struct FoldUnits { int pm; __device__ __forceinline__ bool next(int i, pg8::Unit& u) const { if (i >= 4) return false; u.pm = pm; u.pn = i; return true; } };
            pg8::Gemm1 gf{W_B, WPc, 1024, 256, 256, 256}; FoldUnits Sf{vcu};
            pg8::EpiBf16 Ef{(bf16_t*)(ws + WS_WBF), 1024, nullptr};
            pg8::gemm_phase<pg8::EpiBf16, FoldUnits, pg8::Gemm1>(lds + RING_OFF, gf, Sf, Ef, wave);
        }
    } else {
        PHASE_IDS();
        const bool split = p0_split;
        const bool defer_wdown = (G == 256);
        const int gwb = split ? (vcu - MKV_CUS) * NWAVES + wave : gw, NGWB = split ? (G - MKV_CUS) * NWAVES : NGW;
        LAS float* scr = (LAS float*)(lds + RING_OFF + wave * 16384);
        constexpr int I_IN = 64 * 640, I_A = 32 * 128, I_B = 0, I_C = 16 * 128, I_O = 64 * 128, I_UP = 64 * 688, I_DN = 172 * 128, I_PL = 0;
        constexpr int NITEMS = I_IN + I_A + I_B + I_C + I_O + I_UP + I_DN + I_PL;
        for (int it = gwb; it < NITEMS; it += NGWB) {
            int r = it;
            if (r < I_IN) { const int kb = r / 640, nb = r % 640;
                if (nb < 224) transpose_item(w_in, NIN, 64 * kb, 32 * nb, W_IN, 4096, 32 * nb, scr, lane, g_attn);
                else transpose_item_fp8(w_in, NIN, 64 * kb, 32 * nb, WG8, 4096, 32 * nb - 7168, scr, lane, 64.0f);
                continue; }
            r -= I_IN;
            if (r < I_A) { tr_plain(w_a, 2048, 4096, W_A, scr, r, lane); continue; }
            r -= I_A;
            if (r < I_B) { continue; }
            r -= I_B;
            if (r < I_C) { tr_plain(w_c, 1024, 4096, W_C, scr, r, lane); continue; }
            r -= I_C;
            if (r < I_O) { tr_plain(w_o, 4096, 4096, W_O, scr, r, lane); continue; }
            r -= I_O;
            if (r < I_UP) {
                const int kb = r / 688, nb = r % 688, nd = 32 * nb, tile = nd >> 8, j = nd & 255;
                const int nsrc = (j < 128) ? tile * 128 + j : DFF + tile * 128 + (j - 128);
                transpose_item(w_up, NUP, 64 * kb, nsrc, W_UP, 4096, nd, scr, lane, g_ffn); continue; }
            r -= I_UP;
            if (r < I_DN) { if (!defer_wdown) tr_plain(w_down, DFF, 4096, W_DOWN, scr, r, lane); continue; }
            r -= I_DN;
            (void)r;
        }
        { float* cws = (float*)(ws + WS_CWS);
          for (int i = gwb * 64 + lane; i < 4 * NUP; i += NGWB * 64) { const int k = i / NUP, c = i - k * NUP; const float sc = (c < DFF) ? -LOG2E : -(1.0f / LOG2E);
              cws[i] = ((k < 3) ? conv_w[(size_t)k * NUP + c] : conv_b[c]) * sc; } }
        for (int m = gwb; m < MTOK; m += NGWB) rms_row_4096(x + (size_t)m * DMODEL, g_attn, XB + (size_t)m * DMODEL, lane, H8 + (size_t)m * DMODEL, RS1 + m);
    }
    xcd_barrier(bar, wave);

    {
        pg8::Gemm8 g{H8, WG8, DMODEL}; pg8::StaticOrder S; S.init(MTOK, 13312, G, bx);
        pg8::EpiG8 E{GL, QM, g_qm, (LAS float*)(lds + XCH_OFF)};
        pg8::gemm_phase<pg8::EpiG8, pg8::StaticOrder, pg8::Gemm8>(lds + RING_OFF, g, S, E, wave);
    }
    {
        pg8::Gemm1 g{XB, W_IN, DMODEL, DMODEL, DMODEL, 0}; pg8::StaticOrder S; S.init(MTOK, 7168, G, bx);
        pg8::Unit u0; int pm_base = 0;
        if (S.next(0, u0)) pm_base = u0.pm & ~7;
        { PHASE_IDS();
          LAS float* tab = (LAS float*)(lds + RSTD_OFF);
#pragma unroll
          for (int k = 0; k < 4; ++k) tab[tid + 512 * k] = RS1[pm_base * 256 + tid + 512 * k];
          asm volatile("s_waitcnt lgkmcnt(0)\n\ts_barrier" ::: "memory"); }
        pg8::EpiProj E{QA, UPB, QM, nullptr, (const LAS float*)(lds + RSTD_OFF), pm_base, g_qa, g_ka, g_qm, (LAS float*)(lds + XCH_OFF), ROPE_INV2PI};
        pg8::gemm_phase<pg8::EpiProj, pg8::StaticOrder, pg8::Gemm1>(lds + RING_OFF, g, S, E, wave);
    }
    xcd_barrier(bar, wave);

    {
        PHASE_IDS();
        {
            pg8::StaticOrder S; S.init(MTOK, 1024, G, bx); pg8::Unit pu;
            for (int i = 0; S.next(i, pu); ++i) {
                const int gq = pu.pn, row0 = pu.pm * 256 + (tid >> 5) * 16, c = gq * 32 + (tid & 31);
                const bf16_t* src = UPB + (size_t)row0 * 1024 + c * 8; bf16_t* dst = YP + (size_t)row0 * 1024 + c * 8; const int t0 = row0 & (SEQ - 1);
                if (gq == 0) pool_prep_seg<2>(src, dst, t0); else if (gq == 1) pool_prep_seg<4>(src, dst, t0); else if (gq == 2) pool_prep_seg<8>(src, dst, t0); else pool_prep_seg<16>(src, dst, t0);
            }
        }
        float lam, negb_a;
        {
            const float a1 = lam_q1[lane] * lam_k1[lane] + lam_q1[lane + 64] * lam_k1[lane + 64];
            const float a2 = lam_q2[lane] * lam_k2[lane] + lam_q2[lane + 64] * lam_k2[lane + 64];
            lam = expf(wave_sum(a1)) - expf(wave_sum(a2)) + LAMBDA_INIT;
            const float gq = wave_max(fmaxf(fabsf(g_qa[lane]), fabsf(g_qa[lane + 64]))), gk = wave_max(fmaxf(fabsf(g_ka[lane]), fabsf(g_ka[lane + 64])));
            negb_a = -(11.313708498984761f * LOG2E * 1.02f) * gq * gk;
            lam = __uint_as_float(__builtin_amdgcn_readfirstlane(__float_as_uint(lam))); negb_a = __uint_as_float(__builtin_amdgcn_readfirstlane(__float_as_uint(negb_a)));
        }
        LAS float* wsf = (LAS float*)(lds + WSF_OFF) + wave * 64;
        if (G == 256) {
            const int bh = vcu >> 4, s = vcu & 15, b = bh >> 3, h = bh & 7;
            const int comp = wave >> 2, qg = (wave & 3) ^ (comp << 1);
#pragma unroll 1
            for (int ui = 0; ui < 4; ++ui) {
                const int qb = (ui == 0) ? s : (ui == 1) ? 31 - s : (ui == 2) ? 32 + s : 63 - s;
                const size_t rowbase = (size_t)b * SEQ; const int q0 = qb * 128 + qg * 32;
                f32x4 O[16][2]; float lq[2];
                att::attn_core16(O, lq, QA + (rowbase + q0) * 2048 + h * 256 + comp * 128, 2048, KA + rowbase * 2048 + h * 256, VA + rowbase * 2048 + h * 256, 2048,
                                 2 * qb + 2, 2 * qb + 1 + (qg >> 1), comp * 16, negb_a, lds + RING_OFF, wave);
                int ln = (int)__builtin_amdgcn_mbcnt_hi(~0u, __builtin_amdgcn_mbcnt_lo(~0u, 0u)); asm volatile("" : "+v"(ln));
                const int fr = ln & 15, fq = ln >> 4;
                LAS f32x4* stage = (LAS f32x4*)(lds + RING_OFF + qg * 32768) + ln;
                const float f0 = ((comp == 1) ? lam : 1.0f) * __builtin_amdgcn_rcpf(lq[0]), f1 = ((comp == 1) ? lam : 1.0f) * __builtin_amdgcn_rcpf(lq[1]);
#define DA_FIN(MINE) do { \
                    _Pragma("unroll") for (int db = 0; db < 16; ++db) stage[((1 - (MINE)) * 16 + db) * 64] = O[db][1 - (MINE)] * ((MINE) ? f0 : f1); \
                    asm volatile("s_waitcnt lgkmcnt(0)\n\ts_barrier" ::: "memory"); \
                    const float fm_ = (MINE) ? f1 : f0; float ss = 0.f; \
                    _Pragma("unroll") for (int db = 0; db < 16; ++db) { const f32x4 a_ = O[db][MINE] * fm_, b_ = stage[((MINE) * 16 + db) * 64]; const f32x4 v = (MINE) ? (b_ - a_) : (a_ - b_); O[db][MINE] = v; \
                        ss += (v[0] * v[0] + v[1] * v[1]) + (v[2] * v[2] + v[3] * v[3]); } \
                    ss += sx<16>(ss); ss = sum32x(ss); \
                    const float rn = (1.0f - LAMBDA_INIT) * __builtin_amdgcn_rsqf(ss * (1.f / 256.f) + EPS); \
                    const float* gp = g_subln + 4 * fq; asm volatile("" : "+v"(gp)); \
                    LAS unsigned char* rb_ = lds + RING_OFF + qg * 32768 + (MINE) * 16384;        \
                    _Pragma("unroll") for (int db = 0; db < 16; ++db) { const f32x4 g4 = *(const f32x4*)(gp + 16 * db); const f32x4 v = O[db][MINE] * rn * g4; \
                        u32x2 w; w.x = pk2(v[0], v[1]); w.y = pk2(v[2], v[3]); att::rowbuf_put(rb_, fr, fq, 0, db, w); } \
                    att::rowbuf_store<16>(rb_, ln, YA + (rowbase + q0 + (MINE) * 16) * 2048 + h * 256, 2048); } while (0)
                if (comp == 0) DA_FIN(0); else DA_FIN(1);
#undef DA_FIN
                asm volatile("s_waitcnt lgkmcnt(0)\n\ts_barrier" ::: "memory");
            }
        }
        if (G == 256) {
            PHASE_IDS();
            LAS float* wsf = (LAS float*)(lds + WSF_OFF) + wave * 64;
            const int bhm = vcu >> 5, qb = vcu & 31, b = bhm >> 2, hm = bhm & 3;
            const size_t rowbase = (size_t)b * SEQ; const int q0 = qb * 256 + wave * 32;
            float negb_m;
            { float m1 = 0.f, m2 = 0.f;
#pragma unroll
              for (int j = 0; j < 4; ++j) { m1 = fmaxf(m1, fabsf(g_qm[lane + 64 * j])); m2 = fmaxf(m2, fabsf(g_km[lane + 64 * j])); }
              negb_m = -(16.0f * LOG2E * 1.02f) * wave_max(m1) * wave_max(m2);
              negb_m = __uint_as_float(__builtin_amdgcn_readfirstlane(__float_as_uint(negb_m))); }
            att::mem_attn_core16(QM + (rowbase + q0) * 1024 + hm * 256, 1024, KVM + (size_t)b * MEMLEN * 2048 + hm * 256, KVM + (size_t)b * MEMLEN * 2048 + 1024 + hm * 256, 2048, negb_m, lds + RING_OFF, wave,
                                 YC + (rowbase + q0) * 1024 + hm * 256, 1024);
        }
    }
    xcd_barrier(bar, wave);

    {
        pg8::StaticOrder S; S.init(MTOK, DMODEL, G, bx);
        pg8::Gemm3 g{{YA, YP, YC}, {W_A, (const bf16_t*)(ws + WS_WBF), W_C}, {2048, 1024, 1024}};
        pg8::EpiMerge E{MERGED, GL};
        pg8::gemm_phase<pg8::EpiMerge, pg8::StaticOrder, pg8::Gemm3>(lds + RING_OFF, g, S, E, wave);
    }
    xcd_barrier(bar, wave);

    {
        pg8::Gemm1 g{MERGED, W_O, DMODEL, DMODEL, DMODEL, 0}; pg8::StaticOrder S; S.init(MTOK, DMODEL, G, bx);
        pg8::EpiX1 E{XB, X1B, SSQ};
        pg8::gemm_phase<pg8::EpiX1, pg8::StaticOrder, pg8::Gemm1>(lds + RING_OFF, g, S, E, wave);
    }
    xcd_barrier(bar, wave);

    {
        pg8::Gemm1 g{X1B, W_UP, DMODEL, DMODEL, DMODEL, 0}; pg8::StaticOrder S; S.init(MTOK, NUP, G, bx);
        pg8::Unit u0; int pm_base = 0;
        if (S.next(0, u0)) pm_base = u0.pm & ~7;
        {
            PHASE_IDS();
            LAS float* tab = (LAS float*)(lds + RSTD_OFF);
#pragma unroll 1
            for (int k = 0; k < 4; k += 2) {
                const int lr0 = tid + 512 * k, lr1 = lr0 + 512; const float* p0 = SSQ + (size_t)(pm_base * 256 + lr0) * 64; const float* p1 = p0 + (size_t)512 * 64;
                f32x4 v0[16], v1[16];
#pragma unroll
                for (int j = 0; j < 16; ++j) { v0[j] = *(const f32x4*)(p0 + 4 * j); v1[j] = *(const f32x4*)(p1 + 4 * j); }
                float q0 = 0.f, q1 = 0.f;
#pragma unroll
                for (int j = 0; j < 16; ++j) { q0 += (v0[j][0] + v0[j][1]) + (v0[j][2] + v0[j][3]); q1 += (v1[j][0] + v1[j][1]) + (v1[j][2] + v1[j][3]); }
                tab[lr0] = 1.0f / sqrtf(q0 * (1.f / 4096.f) + EPS); tab[lr1] = 1.0f / sqrtf(q1 * (1.f / 4096.f) + EPS); }
            asm volatile("s_waitcnt lgkmcnt(0)\n\ts_barrier" ::: "memory");
        }
        pg8::EpiUpConv E{ACT, (const float*)(ws + WS_CWS), (const float*)(ws + WS_CWS) + 3 * NUP, HALO, (LAS f32x4*)(lds + XCH_OFF), (const LAS float*)(lds + RSTD_OFF), pm_base};
        pg8::gemm_phase<pg8::EpiUpConv, pg8::StaticOrder, pg8::Gemm1>(lds + RING_OFF, g, S, E, wave);
        pg8::Unit ux;
        if (G == 256 && !S.next(21, ux)) {
            PHASE_IDS();
            LAS float* scr = (LAS float*)(lds + RING_OFF + wave * 16384);
            const int gwi = (bx - 128) * NWAVES + wave;
            if (bx >= 128) for (int it = gwi; it < 172 * 128; it += 128 * NWAVES) tr_plain(w_down, DFF, 4096, W_DOWN, scr, it, lane);
        }
    }
    xcd_barrier(bar, wave);
    {
        PHASE_IDS();
        const int gt = vcu * (NWAVES * 64) + tid, NGT = G * NWAVES * 64;
        for (int idx = gt; idx < 64 * (DFF / 4); idx += NGT) {
            const int pm = idx / (DFF / 4), ch = (idx - pm * (DFF / 4)) * 4;
            if ((pm & 31) == 0) continue;
            f32x4 yy[2][2];
#pragma unroll
            for (int bj = 0; bj < 2; ++bj) { const int col = bj * DFF + ch;
                const f32x4 um2 = *(const f32x4*)(HALO + (size_t)((pm - 1) * 4 + 2) * NUP + col), um1 = *(const f32x4*)(HALO + (size_t)((pm - 1) * 4 + 3) * NUP + col);
                const f32x4 u0v = *(const f32x4*)(HALO + (size_t)(pm * 4 + 0) * NUP + col), u1v = *(const f32x4*)(HALO + (size_t)(pm * 4 + 1) * NUP + col);
                const f32x4 w0 = *(const f32x4*)(conv_w + col), w1 = *(const f32x4*)(conv_w + NUP + col), w2 = *(const f32x4*)(conv_w + 2 * NUP + col), bb = *(const f32x4*)(conv_b + col);
                yy[bj][0] = w2 * u0v + w1 * um1 + w0 * um2 + bb; yy[bj][1] = w2 * u1v + w1 * u0v + w0 * um1 + bb; }
#pragma unroll
            for (int r = 0; r < 2; ++r) { f32x4 y;
#pragma unroll
                for (int e = 0; e < 4; ++e) { const float gv = yy[0][r][e]; y[e] = gv * sigmoidf_fast(gv) * yy[1][r][e]; }
                u32x2 w; w.x = pk2(y[0], y[1]); w.y = pk2(y[2], y[3]); *(u32x2*)(ACT + (size_t)(pm * 256 + r) * DFF + ch) = w; }
        }
    }
    xcd_barrier(bar, wave);

    {
        pg8::Gemm1 g{ACT, W_DOWN, DFF, DFF, DFF, 0}; pg8::StaticOrder S; S.init(MTOK, DMODEL, G, bx);
        pg8::EpiOut E{X1B, out};
        pg8::gemm_phase<pg8::EpiOut, pg8::StaticOrder, pg8::Gemm1>(lds + RING_OFF, g, S, E, wave);
    }
}

extern "C" void kernel_launch(void* const* d_in, const int* in_sizes, int n_in, void* d_out, int out_size, void* d_ws, size_t ws_size, hipStream_t stream) {
    static int grid = 0;
    if (grid == 0) {
        if (n_in != 26 || in_sizes[0] != MTOK * DMODEL || out_size != MTOK * DMODEL || ws_size < WS_END) {
            fprintf(stderr, "kernel_launch: unexpected shapes: n_in %d in0 %d out %d ws %zu (need %zu)\n", n_in, n_in > 0 ? in_sizes[0] : -1, out_size, ws_size, (size_t)WS_END); grid = -1; return; }
        int dev = 0, cus = 0, per_cu = 0;
        if (hipGetDevice(&dev) != hipSuccess || hipDeviceGetAttribute(&cus, hipDeviceAttributeMultiprocessorCount, dev) != hipSuccess) { grid = -1; return; }
        if (hipFuncSetAttribute((const void*)mk_fwd, hipFuncAttributeMaxDynamicSharedMemorySize, LDS_BYTES) != hipSuccess) { fprintf(stderr, "kernel_launch: hipFuncSetAttribute failed\n"); grid = -1; return; }
        if (hipOccupancyMaxActiveBlocksPerMultiprocessor(&per_cu, (const void*)mk_fwd, NWAVES * 64, LDS_BYTES) != hipSuccess || per_cu < 1)
            fprintf(stderr, "kernel_launch: note: occupancy query reports %d workgroups per CU\n", per_cu);
        (void)hipGetLastError();
        grid = cus;
        if (grid != 256) fprintf(stderr, "kernel_launch: %d CUs; the attention phase is dealt for 256\n", grid);
    }
    if (grid < 0) return;
    if (hipMemsetAsync((char*)d_ws + WS_CTL, 0, CTL_ZERO_BYTES, stream) != hipSuccess) return;
    Args a{};
    for (int i = 0; i < 26; ++i) a.in[i] = (const float*)d_in[i];
    a.out = (float*)d_out; a.ws = (unsigned char*)d_ws;
    hipLaunchKernelGGL(mk_fwd, dim3(grid), dim3(NWAVES * 64), LDS_BYTES, stream, a);
}
```

```cpp
#include <hip/hip_runtime.h>
#include <cstdio>
#include <cstdint>

#define LAS __attribute__((address_space(3)))
#define GAS __attribute__((address_space(1)))
typedef unsigned short bf16_t;
typedef short bf16x8 __attribute__((ext_vector_type(8)));
typedef short s16x4 __attribute__((ext_vector_type(4)));
typedef float f32x2 __attribute__((ext_vector_type(2)));
typedef float f32x4 __attribute__((ext_vector_type(4)));
typedef float f32x16 __attribute__((ext_vector_type(16)));
typedef unsigned u32x2 __attribute__((ext_vector_type(2)));
typedef unsigned u32x4 __attribute__((ext_vector_type(4)));
typedef __bf16 bf16x2_t __attribute__((ext_vector_type(2)));
typedef int v8i32 __attribute__((ext_vector_type(8)));

constexpr int BATCH = 2, SEQ = 8192, DMODEL = 4096, MTOK = BATCH * SEQ;
constexpr int NIN = 20480, DFF = 11008, NUP = 2 * DFF, MEMLEN = 256, MROWS = BATCH * MEMLEN;
constexpr float EPS = 1e-6f, LOG2E = 1.4426950408889634f;
constexpr float LAMBDA_INIT = 0.2f;
constexpr int NWAVES = 8;

constexpr size_t MiB = 1u << 20;
constexpr size_t WS_CTL = 0, CTL_ZERO_BYTES = 32768;
constexpr size_t WS_WUP = 2 * MiB;
constexpr size_t WS_WDOWN = 174 * MiB;
constexpr size_t WS_WIN = 260 * MiB;
constexpr size_t WS_WG8 = 324 * MiB;
constexpr size_t DO_H8 = 128 * MiB;
constexpr size_t WS_WA = 420 * MiB;
constexpr size_t WS_WB = 436 * MiB;
constexpr size_t WS_WC = 444 * MiB;
constexpr size_t WS_WO = 452 * MiB;
constexpr size_t WS_WMKV = 484 * MiB;
constexpr size_t WS_WPOOL = 500 * MiB;
constexpr size_t WS_KVM = 501 * MiB;
constexpr size_t WS_HM = 503 * MiB;
constexpr size_t WS_QA = 508 * MiB, WS_KA = 572 * MiB, WS_VA = 636 * MiB;
constexpr size_t WS_UP = 700 * MiB, WS_QM = 732 * MiB;
constexpr size_t WS_GL = 764 * MiB;
constexpr size_t WS_YP = 1148 * MiB;
constexpr size_t WS_MERGED = 508 * MiB;
constexpr size_t WS_X1B = 260 * MiB;
constexpr size_t WS_ACT = 852 * MiB;
constexpr size_t WS_SSQ = 1196 * MiB;
constexpr size_t WS_HALO = 1200 * MiB;
constexpr size_t WS_WBF = 960 * MiB;
constexpr size_t WS_WPF = 968 * MiB;
constexpr size_t WS_END = 1222 * MiB;
constexpr size_t DO_YA = 192 * MiB, DO_YB = 128 * MiB, DO_YC = 160 * MiB;
constexpr size_t WS_CWS = 1 * MiB + 256 * 1024;
constexpr size_t WS_RS1 = 1 * MiB;

constexpr int CW_TMO = 0;
constexpr int CW_BAR = 4096;
constexpr int CW_P0A = 64;

constexpr int RING_OFF = 0, RING_BYTES = 131072;
constexpr int LDSCTL_OFF = RING_BYTES, MISC_OFF = LDSCTL_OFF + 320;
constexpr int WSF_OFF = RING_BYTES + 1024;
constexpr int XCH_OFF = RING_BYTES + 4096;
constexpr int RSTD_OFF = RING_BYTES + 12288;
constexpr int LDS_BYTES = 155648;

__device__ __forceinline__ float bflo(unsigned w) { return __uint_as_float(w << 16); }
__device__ __forceinline__ float bfhi(unsigned w) { return __uint_as_float(w & 0xffff0000u); }
__device__ __forceinline__ unsigned pk2(float lo, float hi) { f32x2 v = {lo, hi}; bf16x2_t b = __builtin_convertvector(v, bf16x2_t); return __builtin_bit_cast(unsigned, b); }
__device__ __forceinline__ float sigmoidf_fast(float a) { return __builtin_amdgcn_rcpf(1.0f + __builtin_amdgcn_exp2f(-LOG2E * a)); }
template <int K> __device__ __forceinline__ float sx(float v) { return __int_as_float(__builtin_amdgcn_ds_swizzle(__float_as_int(v), (K << 10) | 0x1f)); }
__device__ __forceinline__ float sum32x(float v) { auto rr = __builtin_amdgcn_permlane32_swap(__float_as_uint(v), __float_as_uint(v), false, false); return __uint_as_float(rr[0]) + __uint_as_float(rr[1]); }
__device__ __forceinline__ float max32x(float v) { auto rr = __builtin_amdgcn_permlane32_swap(__float_as_uint(v), __float_as_uint(v), false, false); return fmaxf(__uint_as_float(rr[0]), __uint_as_float(rr[1])); }
__device__ __forceinline__ float wave_sum(float v) { v += sx<1>(v); v += sx<2>(v); v += sx<4>(v); v += sx<8>(v); v += sx<16>(v); return sum32x(v); }
__device__ __forceinline__ float wave_max(float v) { v = fmaxf(v, sx<1>(v)); v = fmaxf(v, sx<2>(v)); v = fmaxf(v, sx<4>(v)); v = fmaxf(v, sx<8>(v)); v = fmaxf(v, sx<16>(v)); return max32x(v); }
__device__ __forceinline__ void unpack8(const u32x4 w, float (&f)[8]) { f[0] = bflo(w.x); f[1] = bfhi(w.x); f[2] = bflo(w.y); f[3] = bfhi(w.y); f[4] = bflo(w.z); f[5] = bfhi(w.z); f[6] = bflo(w.w); f[7] = bfhi(w.w); }
__device__ __forceinline__ unsigned pk4_fp8(float a, float b, float c, float d) { int p = __builtin_amdgcn_cvt_pk_fp8_f32(a, b, 0, false); p = __builtin_amdgcn_cvt_pk_fp8_f32(c, d, p, true); return (unsigned)p; }
__device__ __forceinline__ void gate_unpack8(const u32x2 w, float (&f)[8]) { f[0] = (float)(w.x & 0xffu); f[1] = (float)((w.x >> 8) & 0xffu); f[2] = (float)((w.x >> 16) & 0xffu); f[3] = (float)(w.x >> 24);
                                                                            f[4] = (float)(w.y & 0xffu); f[5] = (float)((w.y >> 8) & 0xffu); f[6] = (float)((w.y >> 16) & 0xffu); f[7] = (float)(w.y >> 24); }
#define LDS_WAIT() asm volatile("s_waitcnt lgkmcnt(0)" ::: "memory")
#define VM_WAIT() asm volatile("s_waitcnt vmcnt(0)" ::: "memory")

namespace pg8 {
constexpr int BM = 256, BK = 64, HALF = 128, HTB = HALF * BK * 2, STAGE_BYTES = 8 * HTB, NXCD = 8, WGM = 8;
__host__ __device__ __forceinline__ int lds_byte(int r, int c) { const int st = (r >> 4) * 2 + (c >> 5), rr = r & 15, cc = c & 31, ob = rr * 64 + cc * 2; return st * 1024 + (ob ^ (((ob >> 9) & 1) << 5)); }
__host__ __device__ __forceinline__ void stage_rc(int b, int& R, int& C) { const int st = b / 1024, sb = b % 1024, swz = sb ^ (((sb >> 9) & 1) << 5); R = (st >> 1) * 16 + swz / 64; C = (st & 1) * 32 + (swz % 64) / 2; }
__host__ __device__ __forceinline__ int lds_byte2(int r, int c) { const int rr = r & 7, q = c >> 3; return (r >> 3) * 1024 + rr * 128 + ((q ^ (((rr >> 1) & 3) << 1)) << 4); }
__host__ __device__ __forceinline__ void stage_rc2(int b, int& R, int& C) { const int blk = b / 1024, sb = b % 1024, rr = sb / 128, pos = (sb % 128) / 16; R = blk * 8 + rr; C = (pos ^ (((rr >> 1) & 3) << 1)) * 8; }
__host__ __device__ __forceinline__ int perm32(int rho) { const int n = rho >> 4, i = rho & 15; return 8 * (i >> 2) + 4 * n + (i & 3); }

struct Unit { int pm, pn; };

struct StaticOrder {
    int nM, nN, nwg, G, c;
    __device__ void init(int M, int N, int G_, int c_) { nM = M / BM; nN = N / BM; nwg = nM * nN; G = G_; c = c_; }
    __device__ bool next(int i, Unit& u) const {
        const long L = (long)i * G + c; if (L >= nwg) return false;
        int wgid = (int)L; { const int q = nwg / NXCD, r = nwg % NXCD, xcd = wgid % NXCD, off = wgid / NXCD; wgid = (xcd < r ? xcd * (q + 1) : r * (q + 1) + (xcd - r) * q) + off; }
        const int nig = WGM * nN, gid = wgid / nig, fm = gid * WGM, gsz = (nM - fm) < WGM ? (nM - fm) : WGM;
        u.pm = fm + ((wgid % nig) % gsz); u.pn = (wgid % nig) / gsz; return true;
    }
};

typedef f32x4 Acc[2][2][4][2];

struct TileOut { bf16_t* base; int ld, colt, mode; const float* g; float scale; };
__device__ __forceinline__ void norm_store(Acc& acc, const Unit& u, const TileOut t, LAS float* xch, const float* inv2pi, int wr, int wc, int fr, int fq) {
    asm volatile("" : "+v"(fq), "+v"(fr));
    const int lrow = wr * 64 + fr;
    if (t.mode >= 2) {
        f32x4 gv[2][2];
#pragma unroll
        for (int bj = 0; bj < 2; ++bj)
#pragma unroll
            for (int n = 0; n < 2; ++n) gv[bj][n] = *(const f32x4*)(t.g + (t.mode == 3 ? bj * HALF : 0) + wc * 32 + 8 * fq + 4 * n);
#pragma unroll
        for (int ai = 0; ai < 2; ++ai)
#pragma unroll
            for (int m = 0; m < 4; ++m)
#pragma unroll
                for (int bj = 0; bj < 2; ++bj) { const f32x4 a = acc[ai][bj][m][0], b = acc[ai][bj][m][1];
                    float q = (a[0] * a[0] + a[1] * a[1]) + (a[2] * a[2] + a[3] * a[3]) + (b[0] * b[0] + b[1] * b[1]) + (b[2] * b[2] + b[3] * b[3]);
                    q += sx<16>(q); q = sum32x(q);
                    if (fq == 0) xch[((lrow + ai * HALF + m * 16) * 2 + bj) * 4 + wc] = q; }
        asm volatile("s_waitcnt lgkmcnt(0)\n\ts_barrier" ::: "memory");
#pragma unroll
        for (int ai = 0; ai < 2; ++ai)
#pragma unroll
            for (int m = 0; m < 4; ++m) {
                const f32x4 p0 = *(const LAS f32x4*)(xch + ((lrow + ai * HALF + m * 16) * 2 + 0) * 4), p1 = *(const LAS f32x4*)(xch + ((lrow + ai * HALF + m * 16) * 2 + 1) * 4);
                const float s0 = (p0[0] + p0[1]) + (p0[2] + p0[3]), s1 = (p1[0] + p1[1]) + (p1[2] + p1[3]);
                float r0, r1;
                if (t.mode == 3) { r0 = r1 = t.scale * __builtin_amdgcn_rsqf((s0 + s1) * (1.f / 256.f) + EPS); } else { r0 = t.scale * __builtin_amdgcn_rsqf(s0 * (1.f / 128.f) + EPS); r1 = t.scale * __builtin_amdgcn_rsqf(s1 * (1.f / 128.f) + EPS); }
#pragma unroll
                for (int n = 0; n < 2; ++n) { acc[ai][0][m][n] = acc[ai][0][m][n] * r0 * gv[0][n]; acc[ai][1][m][n] = acc[ai][1][m][n] * r1 * gv[1][n]; } }
        if (t.mode == 2) {
            if (wc == 0) {
                f32x4 iv[2];
#pragma unroll
                for (int n = 0; n < 2; ++n) iv[n] = *(const f32x4*)(inv2pi + 8 * (fq & 1) + 4 * n);
                const float sgn = (fq < 2) ? -1.0f : 1.0f;
#pragma unroll
                for (int ai = 0; ai < 2; ++ai)
#pragma unroll
                    for (int m = 0; m < 4; ++m) { const float fp = (float)((u.pm * BM + lrow + ai * HALF + m * 16) & (SEQ - 1));
#pragma unroll
                        for (int n = 0; n < 2; ++n)
#pragma unroll
                            for (int e = 0; e < 4; ++e) { const float rev = __builtin_amdgcn_fractf(fp * iv[n][e]); const float c = __builtin_amdgcn_cosf(rev), sn = __builtin_amdgcn_sinf(rev) * sgn;
#pragma unroll
                                for (int bj = 0; bj < 2; ++bj) { const float v = acc[ai][bj][m][n][e];
                                    auto rr = __builtin_amdgcn_permlane32_swap(__float_as_uint(v), __float_as_uint(v), false, false);
                                    const float other = __uint_as_float(fq < 2 ? rr[1] : rr[0]);
                                    acc[ai][bj][m][n][e] = v * c + other * sn; } } }
            }
        }
    }
    const int row0 = u.pm * BM + lrow, col0 = t.colt + wc * 32 + 8 * fq;
#pragma unroll
    for (int ai = 0; ai < 2; ++ai)
#pragma unroll
        for (int m = 0; m < 4; ++m) { bf16_t* rowp = t.base + (size_t)(row0 + ai * HALF + m * 16) * t.ld + col0;
#pragma unroll
            for (int bj = 0; bj < 2; ++bj) { f32x4 v0 = acc[ai][bj][m][0], v1 = acc[ai][bj][m][1];
                if (t.mode == 1) {
#pragma unroll
                    for (int e = 0; e < 4; ++e) { v0[e] = sigmoidf_fast(v0[e]); v1[e] = sigmoidf_fast(v1[e]); } }
                u32x4 w; w.x = pk2(v0[0], v0[1]); w.y = pk2(v0[2], v0[3]); w.z = pk2(v1[0], v1[1]); w.w = pk2(v1[2], v1[3]);
                *(u32x4*)(rowp + bj * HALF) = w; } }
}
struct EpiProj {
    static constexpr bool PERM = true;
    bf16_t* qa; bf16_t* up; bf16_t* qm; bf16_t* gl;
    const LAS float* rs; int pm_base;
    const float* g_qa; const float* g_ka; const float* g_qm; LAS float* xch; const float* inv2pi;
    __device__ __forceinline__ void operator()(Acc& acc, const Unit& u, int wr, int wc, int fr, int fq) const {
        { const LAS float* rp = rs + (u.pm - pm_base) * BM + wr * 64 + fr; float r8[8];
#pragma unroll
          for (int i = 0; i < 8; ++i) r8[i] = rp[(i >> 2) * HALF + (i & 3) * 16];
#pragma unroll
          for (int ai = 0; ai < 2; ++ai)
#pragma unroll
              for (int m = 0; m < 4; ++m)
#pragma unroll
                  for (int bj = 0; bj < 2; ++bj)
#pragma unroll
                      for (int n = 0; n < 2; ++n) acc[ai][bj][m][n] *= r8[ai * 4 + m]; }
        const int pn = u.pn; TileOut t;
        if (pn < 8) { t.base = qa; t.ld = 2048; t.colt = pn * 256; t.mode = 2; t.g = g_qa; t.scale = 0.08838834764831845f * LOG2E; }
        else if (pn < 16) { t.base = qa + (size_t)MTOK * 2048; t.ld = 2048; t.colt = (pn - 8) * 256; t.mode = 2; t.g = g_ka; t.scale = 1.0f; }
        else if (pn < 24) { t.base = qa + (size_t)2 * MTOK * 2048; t.ld = 2048; t.colt = (pn - 16) * 256; t.mode = 0; t.g = nullptr; t.scale = 1.0f; }
        else if (pn < 28) { t.base = up; t.ld = 1024; t.colt = (pn - 24) * 256; t.mode = 0; t.g = nullptr; t.scale = 1.0f; }
        else if (pn < 32) { t.base = qm; t.ld = 1024; t.colt = (pn - 28) * 256; t.mode = 3; t.g = g_qm; t.scale = 0.0625f * LOG2E; }
        else { t.base = gl; t.ld = 12288; t.colt = (pn - 32) * 256; t.mode = 1; t.g = nullptr; t.scale = 1.0f; }
        norm_store(acc, u, t, xch, inv2pi, wr, wc, fr, fq);
    }
};
struct EpiG8 {
    static constexpr bool PERM = true;
    unsigned char* gl; bf16_t* qm; const float* g_qm; LAS float* xch;
    __device__ __forceinline__ void operator()(Acc& acc, const Unit& u, int wr, int wc, int fr, int fq) const {
        if (u.pn < 4) {
#pragma unroll
            for (int ai = 0; ai < 2; ++ai)
#pragma unroll
                for (int bj = 0; bj < 2; ++bj)
#pragma unroll
                    for (int m = 0; m < 4; ++m)
#pragma unroll
                        for (int n = 0; n < 2; ++n) acc[ai][bj][m][n] = acc[ai][bj][m][n] * 0.015625f;
            TileOut t; t.base = qm; t.ld = 1024; t.colt = u.pn * 256; t.mode = 3; t.g = g_qm; t.scale = 0.0625f * LOG2E;
            norm_store(acc, u, t, xch, nullptr, wr, wc, fr, fq);
            return;
        }
        unsigned char* tp = gl + ((size_t)(u.pm * 48 + (u.pn - 4)) << 16) + (wr * 4 + wc) * 8192 + (fq * 16 + fr) * 16;
#pragma unroll
        for (int ai = 0; ai < 2; ++ai)
#pragma unroll
            for (int m = 0; m < 4; ++m) { u32x4 w4;
#pragma unroll
                for (int bj = 0; bj < 2; ++bj) { const f32x4 v0 = acc[ai][bj][m][0], v1 = acc[ai][bj][m][1];
                    unsigned lo = 0u, hi = 0u;
#pragma unroll
                    for (int e = 0; e < 4; ++e) {
                        const float q0 = __builtin_amdgcn_rcpf((1.0f / 255.0f) + __builtin_amdgcn_exp2f(__builtin_fmaf(v0[e], -LOG2E * 0.015625f, -7.99435343685886f)));
                        const float q1 = __builtin_amdgcn_rcpf((1.0f / 255.0f) + __builtin_amdgcn_exp2f(__builtin_fmaf(v1[e], -LOG2E * 0.015625f, -7.99435343685886f)));
                        lo = __builtin_amdgcn_cvt_pk_u8_f32(fmaxf(q0 + 0.5f, 1.0f), e, lo); hi = __builtin_amdgcn_cvt_pk_u8_f32(fmaxf(q1 + 0.5f, 1.0f), e, hi); }
                    if (bj == 0) { w4.x = lo; w4.y = hi; } else { w4.z = lo; w4.w = hi; } }
                *(u32x4*)(tp + (ai * 4 + m) * 1024) = w4; }
    }
};
struct EpiKvm {
    static constexpr bool PERM = true;
    bf16_t* kvm; const float* g_km; LAS float* xch;
    __device__ __forceinline__ void operator()(Acc& acc, const Unit& u, int wr, int wc, int fr, int fq) const {
        TileOut t; t.base = kvm; t.ld = 2048; t.colt = u.pn * 256; t.mode = (u.pn < 4) ? 3 : 0; t.g = g_km; t.scale = 1.0f;
        norm_store(acc, u, t, xch, nullptr, wr, wc, fr, fq);
    }
};
struct EpiBf16 {
    static constexpr bool PERM = true;
    bf16_t* O; int ldc; const float* colscale;
    __device__ __forceinline__ void operator()(const Acc& acc, const Unit& u, int wr, int wc, int fr, int fq) const {
        const int row0 = u.pm * BM + wr * 64 + fr, col0 = u.pn * BM + wc * 32 + 8 * fq;
        f32x4 sv[2][2];
#pragma unroll
        for (int bj = 0; bj < 2; ++bj)
#pragma unroll
            for (int n = 0; n < 2; ++n) sv[bj][n] = colscale ? *(const f32x4*)(colscale + col0 + bj * HALF + 4 * n) : (f32x4){1.f, 1.f, 1.f, 1.f};
#pragma unroll
        for (int ai = 0; ai < 2; ++ai)
#pragma unroll
            for (int m = 0; m < 4; ++m) { bf16_t* rowp = O + (size_t)(row0 + ai * HALF + m * 16) * ldc + col0;
#pragma unroll
                for (int bj = 0; bj < 2; ++bj) { const f32x4 v0 = acc[ai][bj][m][0] * sv[bj][0], v1 = acc[ai][bj][m][1] * sv[bj][1];
                    u32x4 w; w.x = pk2(v0[0], v0[1]); w.y = pk2(v0[2], v0[3]); w.z = pk2(v1[0], v1[1]); w.w = pk2(v1[2], v1[3]);
                    *(u32x4*)(rowp + bj * HALF) = w; } }
    }
};
struct EpiMerge {
    static constexpr bool PERM = true;
    bf16_t* O; const unsigned char* gate;
    __device__ __forceinline__ void mid(Acc& acc, const Unit& u, int s, int wr, int wc, int fr, int fq) const {
        int lo = (wr * 4 + wc) * 8192 + (fq * 16 + fr) * 16; asm volatile("" : "+v"(lo));
        const unsigned char* gp = gate + ((size_t)(u.pm * 48 + s * 16 + u.pn) << 16) + lo;
        u32x4 G[8][2];
#pragma unroll
        for (int i = 0; i < 8; ++i) { G[i][0] = __builtin_nontemporal_load((const u32x4*)(gp + i * 1024)); G[i][1] = __builtin_nontemporal_load((const u32x4*)(gp + (1 << 20) + i * 1024)); }
#pragma unroll
        for (int i = 0; i < 8; ++i) { const int ai = i >> 2, m = i & 3;
#pragma unroll
            for (int bj = 0; bj < 2; ++bj) {
                const u32x4 ga = G[i][0], gb = G[i][1];
                const u32x2 wa = bj == 0 ? (u32x2){ga.x, ga.y} : (u32x2){ga.z, ga.w}, wb = bj == 0 ? (u32x2){gb.x, gb.y} : (u32x2){gb.z, gb.w};
                float fa[8], fb[8]; gate_unpack8(wa, fa); gate_unpack8(wb, fb);
#pragma unroll
                for (int e = 0; e < 8; ++e) fa[e] = fa[e] * __builtin_amdgcn_rcpf(fb[e]);
                f32x4& v0 = acc[ai][bj][m][0]; f32x4& v1 = acc[ai][bj][m][1];
                v0[0] *= fa[0]; v0[1] *= fa[1]; v0[2] *= fa[2]; v0[3] *= fa[3]; v1[0] *= fa[4]; v1[1] *= fa[5]; v1[2] *= fa[6]; v1[3] *= fa[7]; }
            __builtin_amdgcn_sched_barrier(0); }
    }
    __device__ __forceinline__ void operator()(const Acc& acc, const Unit& u, int wr, int wc, int fr, int fq) const {
        const int row0 = u.pm * BM + wr * 64 + fr, col0 = u.pn * BM + wc * 32 + 8 * fq;
        const unsigned char* gp = gate + ((size_t)(u.pm * 48 + 32 + u.pn) << 16) + (wr * 4 + wc) * 8192 + (fq * 16 + fr) * 16;
        u32x4 G2[8];
#pragma unroll
        for (int i = 0; i < 8; ++i) G2[i] = __builtin_nontemporal_load((const u32x4*)(gp + i * 1024));
        __builtin_amdgcn_sched_barrier(0);
#pragma unroll
        for (int ai = 0; ai < 2; ++ai)
#pragma unroll
            for (int m = 0; m < 4; ++m) { const size_t r = (size_t)(row0 + ai * HALF + m * 16);
                const u32x4 g4 = G2[ai * 4 + m];
#pragma unroll
                for (int bj = 0; bj < 2; ++bj) {
                    const u32x2 gw = bj == 0 ? (u32x2){g4.x, g4.y} : (u32x2){g4.z, g4.w};
                    float fg[8]; gate_unpack8(gw, fg);
#pragma unroll
                    for (int e = 0; e < 8; ++e) fg[e] *= (1.0f / 255.0f);
                    const f32x4 v0 = acc[ai][bj][m][0], v1 = acc[ai][bj][m][1];
                    u32x4 w; w.x = pk2(v0[0] * fg[0], v0[1] * fg[1]); w.y = pk2(v0[2] * fg[2], v0[3] * fg[3]); w.z = pk2(v1[0] * fg[4], v1[1] * fg[5]); w.w = pk2(v1[2] * fg[6], v1[3] * fg[7]);
                    *(u32x4*)(O + r * 4096 + col0 + bj * HALF) = w; } }
    }
};
struct EpiX1 {
    static constexpr bool PERM = true;
    const bf16_t* base; bf16_t* xb; float* ssq;
    __device__ __forceinline__ void operator()(const Acc& acc, const Unit& u, int wr, int wc, int fr, int fq) const {
        const int row0 = u.pm * BM + wr * 64 + fr, col0 = u.pn * BM + wc * 32 + 8 * fq;
        u32x4 X[8];
#define X1_LOAD(slot, s_) X[slot] = __builtin_nontemporal_load((const u32x4*)(base + (size_t)(row0 + ((s_) >> 3) * HALF + (((s_) >> 1) & 3) * 16) * DMODEL + col0 + ((s_) & 1) * HALF))
#pragma unroll
        for (int s_ = 0; s_ < 8; ++s_) X1_LOAD(s_, s_);
        __builtin_amdgcn_sched_barrier(0);
        float q = 0.f;
#pragma unroll
        for (int s_ = 0; s_ < 16; ++s_) { const int ai = s_ >> 3, m = (s_ >> 1) & 3, bj = s_ & 1;
            const int row = row0 + ai * HALF + m * 16; const size_t off = (size_t)row * DMODEL + col0;
            const u32x4 rw = X[s_ & 7];
            if (s_ + 8 < 16) X1_LOAD(s_ & 7, s_ + 8);
            f32x4 v0 = acc[ai][bj][m][0], v1 = acc[ai][bj][m][1];
            v0[0] += bflo(rw.x); v0[1] += bfhi(rw.x); v0[2] += bflo(rw.y); v0[3] += bfhi(rw.y); v1[0] += bflo(rw.z); v1[1] += bfhi(rw.z); v1[2] += bflo(rw.w); v1[3] += bfhi(rw.w);
            u32x4 w; w.x = pk2(v0[0], v0[1]); w.y = pk2(v0[2], v0[3]); w.z = pk2(v1[0], v1[1]); w.w = pk2(v1[2], v1[3]); *(u32x4*)(xb + off + bj * HALF) = w;
            q += ((v0[0] * v0[0] + v0[1] * v0[1]) + (v0[2] * v0[2] + v0[3] * v0[3])) + ((v1[0] * v1[0] + v1[1] * v1[1]) + (v1[2] * v1[2] + v1[3] * v1[3]));
            if (bj == 1) { q += sx<16>(q); q = sum32x(q);
                if (fq == 0) ssq[(size_t)row * 64 + u.pn * 4 + wc] = q;
                q = 0.f; }
            __builtin_amdgcn_sched_barrier(0); }
#undef X1_LOAD
    }
};
struct EpiOut {
    static constexpr bool PERM = true;
    const bf16_t* resid; float* out;
    __device__ __forceinline__ void operator()(const Acc& acc, const Unit& u, int wr, int wc, int fr, int fq) const {
        const int row0 = u.pm * BM + wr * 64 + fr, col0 = u.pn * BM + wc * 32 + 8 * fq;
        u32x4 R[16];
#pragma unroll
        for (int s_ = 0; s_ < 16; ++s_) R[s_] = __builtin_nontemporal_load((const u32x4*)(resid + (size_t)(row0 + (s_ >> 3) * HALF + ((s_ >> 1) & 3) * 16) * DMODEL + col0 + (s_ & 1) * HALF));
        __builtin_amdgcn_sched_barrier(0);
#pragma unroll
        for (int ai = 0; ai < 2; ++ai)
#pragma unroll
            for (int m = 0; m < 4; ++m) { const size_t off = (size_t)(row0 + ai * HALF + m * 16) * DMODEL + col0;
#pragma unroll
                for (int bj = 0; bj < 2; ++bj) { const u32x4 rw = R[(ai * 4 + m) * 2 + bj];
                    f32x4 o0 = acc[ai][bj][m][0], o1 = acc[ai][bj][m][1];
                    o0[0] += bflo(rw.x); o0[1] += bfhi(rw.x); o0[2] += bflo(rw.y); o0[3] += bfhi(rw.y); o1[0] += bflo(rw.z); o1[1] += bfhi(rw.z); o1[2] += bflo(rw.w); o1[3] += bfhi(rw.w);
                    *(f32x4*)(out + off + bj * HALF) = o0; *(f32x4*)(out + off + bj * HALF + 4) = o1; } }
    }
};
template <int CTRL> __device__ __forceinline__ float dpp_f(float old, float src) { return __int_as_float(__builtin_amdgcn_update_dpp(__float_as_int(old), __float_as_int(src), CTRL, 0xf, 0xf, false)); }
template <int CTRL> __device__ __forceinline__ float dppz_f(float src) { return __int_as_float(__builtin_amdgcn_update_dpp(0, __float_as_int(src), CTRL, 0xf, 0xf, true)); }
struct EpiUpConv {
    static constexpr bool PERM = true;
    bf16_t* act; const float* conv_w; const float* conv_b; float* halo; LAS f32x4* xch; const LAS float* rstd; int pm_base;
    __device__ __forceinline__ void operator()(Acc& acc, const Unit& u, int wr, int wc, int fr, int fq) const {
        const int ch = u.pn * 128 + wc * 32 + 8 * fq;
        const LAS float* rs = rstd + (u.pm - pm_base) * 256 + wr * 64 + fr;
#pragma unroll
        for (int ai = 0; ai < 2; ++ai)
#pragma unroll
            for (int m = 0; m < 4; ++m) { const float r = rs[ai * HALF + m * 16];
#pragma unroll
                for (int bj = 0; bj < 2; ++bj)
#pragma unroll
                    for (int n = 0; n < 2; ++n) acc[ai][bj][m][n] *= r; }
        f32x4 CW[2][4];
#define CW_LOAD(buf, g) do { const int col_ = ((g) >> 1) * DFF + ch + 4 * ((g) & 1); \
            CW[buf][0] = *(const f32x4*)(conv_w + col_); CW[buf][1] = *(const f32x4*)(conv_w + NUP + col_); CW[buf][2] = *(const f32x4*)(conv_w + 2 * NUP + col_); CW[buf][3] = *(const f32x4*)(conv_b + col_); } while (0)
        CW_LOAD(0, 0);
        if (fr >= 14) {
#pragma unroll
            for (int ai = 0; ai < 2; ++ai)
#pragma unroll
                for (int bj = 0; bj < 2; ++bj)
#pragma unroll
                    for (int n = 0; n < 2; ++n) xch[((((ai * 2 + wr) * 4 + wc) * 2 + (fr - 14)) * 4 + fq) * 4 + bj * 2 + n] = acc[ai][bj][3][n];
        }
        if (wr == 0 && fr < 2) {
#pragma unroll
            for (int bj = 0; bj < 2; ++bj)
#pragma unroll
                for (int n = 0; n < 2; ++n) *(f32x4*)(halo + (size_t)(u.pm * 4 + fr) * NUP + bj * DFF + ch + 4 * n) = acc[0][bj][0][n];
        }
        if (wr == 1 && fr >= 14) {
#pragma unroll
            for (int bj = 0; bj < 2; ++bj)
#pragma unroll
                for (int n = 0; n < 2; ++n) *(f32x4*)(halo + (size_t)(u.pm * 4 + 2 + (fr - 14)) * NUP + bj * DFF + ch + 4 * n) = acc[1][bj][3][n];
        }
        asm volatile("s_waitcnt lgkmcnt(0)\n\ts_barrier" ::: "memory");
#pragma unroll
        for (int bj = 0; bj < 2; ++bj)
#pragma unroll
            for (int n = 0; n < 2; ++n) {
                const int gi = bj * 2 + n;
                if (gi + 1 < 4) CW_LOAD((gi + 1) & 1, gi + 1);
                const f32x4 w0 = CW[gi & 1][0], w1 = CW[gi & 1][1], w2 = CW[gi & 1][2], bb = CW[gi & 1][3];
                const f32x4 w1z = (fr == 0) ? w1 : (f32x4){0.f, 0.f, 0.f, 0.f}, w0z = (fr < 2) ? w0 : (f32x4){0.f, 0.f, 0.f, 0.f};
#pragma unroll
                for (int ai = 0; ai < 2; ++ai) {
                    const bool has = (wr == 1) || (ai == 1);
                    const int pai = (wr == 1) ? ai : 0, pwr = (wr == 1) ? 0 : 1;
                    f32x4 P = (f32x4){0.f, 0.f, 0.f, 0.f};
                    if (has && fr >= 14) P = xch[((((pai * 2 + pwr) * 4 + wc) * 2 + (fr - 14)) * 4 + fq) * 4 + bj * 2 + n];
#pragma unroll
                    for (int m = 3; m >= 0; --m) {
                        const f32x4 cur = acc[ai][bj][m][n]; const f32x4 prv = (m > 0) ? acc[ai][bj][m - 1][n] : P; f32x4 y;
#pragma unroll
                        for (int e = 0; e < 4; ++e) {
                            float t = w2[e] * cur[e] + bb[e];
                            asm("v_fmac_f32_dpp %0, %1, %2 row_shr:1 row_mask:0xf bank_mask:0xf bound_ctrl:1" : "+v"(t) : "v"(cur[e]), "v"(w1[e]));
                            asm("v_fmac_f32_dpp %0, %1, %2 row_shr:2 row_mask:0xf bank_mask:0xf bound_ctrl:1" : "+v"(t) : "v"(cur[e]), "v"(w0[e]));
                            asm("v_fmac_f32_dpp %0, %1, %2 row_ror:1 row_mask:0xf bank_mask:0xf" : "+v"(t) : "v"(prv[e]), "v"(w1z[e]));
                            asm("v_fmac_f32_dpp %0, %1, %2 row_ror:2 row_mask:0xf bank_mask:0xf" : "+v"(t) : "v"(prv[e]), "v"(w0z[e]));
                            y[e] = t; }
                        acc[ai][bj][m][n] = y; } }
                asm volatile("" ::: "memory");
#pragma unroll
                for (int ai = 0; ai < 2; ++ai)
#pragma unroll
                    for (int m = 0; m < 4; ++m) asm volatile("" : "+v"(acc[ai][bj][m][n]));
            }
#undef CW_LOAD
        const int row0 = u.pm * BM + wr * 64 + fr;
#pragma unroll
        for (int ai = 0; ai < 2; ++ai)
#pragma unroll
            for (int m = 0; m < 4; ++m) { f32x4 y0, y1;
#pragma unroll
                for (int e = 0; e < 4; ++e) { const float g0 = acc[ai][0][m][0][e], g1 = acc[ai][0][m][1][e];
                    y0[e] = g0 * __builtin_amdgcn_rcpf(1.0f + __builtin_amdgcn_exp2f(g0)) * acc[ai][1][m][0][e]; y1[e] = g1 * __builtin_amdgcn_rcpf(1.0f + __builtin_amdgcn_exp2f(g1)) * acc[ai][1][m][1][e]; }
                u32x4 w; w.x = pk2(y0[0], y0[1]); w.y = pk2(y0[2], y0[3]); w.z = pk2(y1[0], y1[1]); w.w = pk2(y1[2], y1[3]);
                *(u32x4*)(act + (size_t)(row0 + ai * HALF + m * 16) * DFF + ch) = w; }
    }
};

struct Seg { const char* A; const char* B; int lda, ldb, nt; };
struct Gemm1 {
    static constexpr int NSEG = 1; static constexpr bool FP8 = false, UNIFORM = true;
    const bf16_t* A; const bf16_t* Bt; int lda, ldb, K, a_pn_off;
    __device__ __forceinline__ Seg seg(const Unit& u, int) const { Seg s; s.A = (const char*)(A + (size_t)u.pm * BM * lda + (size_t)u.pn * a_pn_off); s.B = (const char*)(Bt + (size_t)u.pn * BM * ldb); s.lda = lda; s.ldb = ldb; s.nt = K / BK; return s; }
};
struct Gemm8 {
    static constexpr int NSEG = 1; static constexpr bool FP8 = true, UNIFORM = true;
    const unsigned char* A; const unsigned char* Bt; int kbytes;
    __device__ __forceinline__ Seg seg(const Unit& u, int) const { Seg s; s.A = (const char*)(A + (size_t)u.pm * BM * kbytes); s.B = (const char*)(Bt + (size_t)u.pn * BM * kbytes); s.lda = kbytes / 2; s.ldb = kbytes / 2; s.nt = kbytes / 128; return s; }
};
struct Gemm3 {
    static constexpr int NSEG = 3; static constexpr bool FP8 = false, UNIFORM = false;
    const bf16_t* A[3]; const bf16_t* Bt[3]; int K[3];
    __device__ __forceinline__ Seg seg(const Unit& u, int i) const { const bf16_t* a = i == 0 ? A[0] : (i == 1 ? A[1] : A[2]); const bf16_t* b = i == 0 ? Bt[0] : (i == 1 ? Bt[1] : Bt[2]); const int k = i == 0 ? K[0] : (i == 1 ? K[1] : K[2]);
        Seg s; s.A = (const char*)(a + (size_t)u.pm * BM * k); s.B = (const char*)(b + (size_t)u.pn * BM * k); s.lda = k; s.ldb = k; s.nt = k / BK; return s; }
};

template <class Epi, class Sched, class GemmT>
__device__ __forceinline__ void gemm_phase(LAS unsigned char* lds, const GemmT& g, const Sched& S, const Epi& E, const int wid) {
    int lane = (int)__builtin_amdgcn_mbcnt_hi(~0u, __builtin_amdgcn_mbcnt_lo(~0u, 0u)); asm volatile("" : "+v"(lane));
    const int tid = wid * 64 + lane, wr = wid >> 2, wc = wid & 3, fr = lane & 15, fq = lane >> 4;
    constexpr int NSEG = GemmT::NSEG;
    int RA[2], RB[2], CC[2];
#pragma unroll
    for (int i = 0; i < 2; ++i) { int R, C; stage_rc2(tid * 16 + i * 8192, R, C); RA[i] = R; RB[i] = Epi::PERM ? ((R & ~31) + perm32(R & 31)) : R; CC[i] = C; }
    const size_t kstep = (size_t)(BK * 2);
    const unsigned ldsw = (unsigned)wid * 1024u;
    const int aoffk[2] = {lds_byte2(wr * 64 + fr, fq * 8), lds_byte2(wr * 64 + fr, 32 + fq * 8)}, boffk[2] = {lds_byte2(wc * 32 + fr, fq * 8), lds_byte2(wc * 32 + fr, 32 + fq * 8)};
#define PG8_SA(b, h) (((b) * 2 + (h)) * HTB)
#define PG8_SB(b, h) ((4 + (b) * 2 + (h)) * HTB)
#define PG8_STAGE(bufoff, gbase, voff) do { _Pragma("unroll") for (int _i = 0; _i < 2; ++_i) \
        __builtin_amdgcn_global_load_lds((const unsigned*)((const char*)(gbase) + (voff)[_i]), (LAS unsigned*)(lds + (bufoff) + ldsw + _i * 8192), 16, 0, 0); } while (0)
#define PG8_LDA(dst, b, h) do { _Pragma("unroll") for (int m = 0; m < 4; ++m) _Pragma("unroll") for (int k = 0; k < 2; ++k) dst[m][k] = *(const LAS bf16x8*)(lds + PG8_SA(b, h) + aoffk[k] + m * 2048); } while (0)
#define PG8_LDB(dst, b, h) do { _Pragma("unroll") for (int n = 0; n < 2; ++n) _Pragma("unroll") for (int k = 0; k < 2; ++k) dst[n][k] = *(const LAS bf16x8*)(lds + PG8_SB(b, h) + boffk[k] + n * 2048); } while (0)
#define PG8_CAT(x) __builtin_bit_cast(v8i32, __builtin_shufflevector(x[0], x[1], 0, 1, 2, 3, 4, 5, 6, 7, 8, 9, 10, 11, 12, 13, 14, 15))
#define PG8_MMA(ai, bj, At, Bt) do { __builtin_amdgcn_s_setprio(1); _Pragma("unroll") for (int m = 0; m < 4; ++m) _Pragma("unroll") for (int n = 0; n < 2; ++n) { \
        if constexpr (GemmT::FP8) asm("v_mfma_scale_f32_16x16x128_f8f6f4 %0, %1, %2, %0, %3, %3 op_sel_hi:[0,0,0]" : "+v"(acc[ai][bj][m][n]) : "v"(PG8_CAT(Bt[n])), "v"(PG8_CAT(At[m])), "v"(sc8));     \
        else { _Pragma("unroll") for (int k = 0; k < 2; ++k) acc[ai][bj][m][n] = __builtin_amdgcn_mfma_f32_16x16x32_bf16(Bt[n][k], At[m][k], acc[ai][bj][m][n], 0, 0, 0); } } __builtin_amdgcn_s_setprio(0); } while (0)
#define PG8_WAIT_V(n) asm volatile("s_waitcnt vmcnt(" #n ")" ::: "memory")
#define PG8_WAIT_L(n) asm volatile("s_waitcnt lgkmcnt(" #n ")" ::: "memory")
#define PG8_BAR __builtin_amdgcn_s_barrier()
#define PG8_SCHED __builtin_amdgcn_sched_barrier(0)
#define PG8_VOFFS(vA, vB, hA, hB, sg) do { _Pragma("unroll") for (int _i = 0; _i < 2; ++_i) { vA[_i] = (unsigned)(RA[_i] * (sg).lda + CC[_i]) * 2u; vB[_i] = (unsigned)(RB[_i] * (sg).ldb + CC[_i]) * 2u; } \
        hA = (size_t)HALF * (sg).lda * 2; hB = (size_t)HALF * (sg).ldb * 2; } while (0)
    Unit cur, nxt; int ui = 0;
    if (!S.next(0, cur)) return;
    Acc acc;
#pragma unroll
    for (int a = 0; a < 2; ++a)
#pragma unroll
        for (int b = 0; b < 2; ++b)
#pragma unroll
            for (int m = 0; m < 4; ++m)
#pragma unroll
                for (int n = 0; n < 2; ++n) acc[a][b][m][n] = (f32x4){0.f, 0.f, 0.f, 0.f};
    bf16x8 At[4][2], B0[2][2], B1[2][2];
    const int sc8 = 0x7f7f7f7f; (void)sc8;
    Seg cs = g.seg(cur, 0);
    unsigned voffA[2], voffB[2]; size_t hstepA, hstepB;
    PG8_VOFFS(voffA, voffB, hstepA, hstepB, cs);
    const char* cA = cs.A; const char* cB = cs.B;
    PG8_STAGE(PG8_SB(0, 0), cB, voffB); PG8_STAGE(PG8_SB(0, 1), cB + hstepB, voffB); PG8_STAGE(PG8_SA(0, 0), cA, voffA); PG8_STAGE(PG8_SA(0, 1), cA + hstepA, voffA);
    if (wr == 1) PG8_BAR;
    PG8_WAIT_V(2); PG8_BAR;
    PG8_STAGE(PG8_SB(1, 0), cB + kstep, voffB); PG8_STAGE(PG8_SA(1, 0), cA + kstep, voffA); PG8_STAGE(PG8_SB(1, 1), cB + hstepB + kstep, voffB);
    PG8_WAIT_V(6); PG8_BAR;
    for (;;) {
        const bool has_next = S.next(ui + 1, nxt);
#pragma unroll 1
        for (int sgi = 0; sgi < NSEG; ++sgi) {
            const Seg ns = (sgi + 1 < NSEG) ? g.seg(cur, sgi + 1) : g.seg(has_next ? nxt : cur, 0);
            unsigned nvA[2], nvB[2]; size_t nhA, nhB;
            if constexpr (GemmT::UNIFORM) { nvA[0] = voffA[0]; nvA[1] = voffA[1]; nvB[0] = voffB[0]; nvB[1] = voffB[1]; nhA = hstepA; nhB = hstepB; }
            else PG8_VOFFS(nvA, nvB, nhA, nhB, ns);
            const int nt = cs.nt;
            for (int t = 0; t < nt; t += 2) {
                const bool last = (t == nt - 2);
                const char* a1 = cA + (size_t)(t + 1) * kstep;
                const char* a2 = last ? ns.A : cA + (size_t)(t + 2) * kstep; const char* b2 = last ? ns.B : cB + (size_t)(t + 2) * kstep;
                const char* a3 = a2 + kstep; const char* b3 = b2 + kstep;
                unsigned vA2[2], vB2[2];
#pragma unroll
                for (int i = 0; i < 2; ++i) { vA2[i] = last ? nvA[i] : voffA[i]; vB2[i] = last ? nvB[i] : voffB[i]; }
                const size_t hA2 = last ? nhA : hstepA, hB2 = last ? nhB : hstepB;
                PG8_LDB(B0, 0, 0); PG8_LDB(B1, 0, 1); PG8_SCHED; PG8_LDA(At, 0, 0); PG8_STAGE(PG8_SA(1, 1), a1 + hstepA, voffA);
                PG8_WAIT_V(8); PG8_WAIT_L(0); PG8_BAR; PG8_MMA(0, 0, At, B0); PG8_MMA(0, 1, At, B1); PG8_BAR; PG8_SCHED;
                PG8_LDA(At, 0, 1); PG8_STAGE(PG8_SB(0, 0), b2, vB2); PG8_STAGE(PG8_SB(0, 1), b2 + hB2, vB2); PG8_STAGE(PG8_SA(0, 0), a2, vA2);
                PG8_WAIT_V(8); PG8_WAIT_L(0); PG8_BAR; PG8_MMA(1, 0, At, B0); PG8_MMA(1, 1, At, B1); PG8_BAR; PG8_SCHED;
                PG8_LDB(B0, 1, 0); PG8_LDB(B1, 1, 1); PG8_SCHED; PG8_LDA(At, 1, 0); PG8_STAGE(PG8_SA(0, 1), a2 + hA2, vA2);
                PG8_WAIT_V(8); PG8_WAIT_L(0); PG8_BAR; PG8_MMA(0, 0, At, B0); PG8_MMA(0, 1, At, B1); PG8_BAR; PG8_SCHED;
                PG8_LDA(At, 1, 1); PG8_STAGE(PG8_SB(1, 0), b3, vB2); PG8_STAGE(PG8_SB(1, 1), b3 + hB2, vB2); PG8_STAGE(PG8_SA(1, 0), a3, vA2);
                PG8_WAIT_V(8); PG8_WAIT_L(0); PG8_BAR; PG8_MMA(1, 0, At, B0); PG8_MMA(1, 1, At, B1); PG8_BAR; PG8_SCHED;
            }
            if constexpr (NSEG > 1) { if (sgi + 1 < NSEG) E.mid(acc, cur, sgi, wr, wc, fr, fq); }
            cs = ns; cA = ns.A; cB = ns.B; hstepA = nhA; hstepB = nhB;
#pragma unroll
            for (int i = 0; i < 2; ++i) { voffA[i] = nvA[i]; voffB[i] = nvB[i]; }
        }
        if (wr == 0) PG8_BAR;
        if constexpr (GemmT::FP8) asm volatile("s_nop 15\n\ts_nop 15" ::: "memory");
        E(acc, cur, wr, wc, fr, fq);
        if (!has_next) break;
#pragma unroll
        for (int a = 0; a < 2; ++a)
#pragma unroll
            for (int b = 0; b < 2; ++b)
#pragma unroll
                for (int m = 0; m < 4; ++m)
#pragma unroll
                    for (int n = 0; n < 2; ++n) acc[a][b][m][n] = (f32x4){0.f, 0.f, 0.f, 0.f};
        cur = nxt; ++ui;
        if (wr == 1) PG8_BAR;
    }
    PG8_WAIT_V(0);
    PG8_BAR;
#undef PG8_SA
#undef PG8_SB
#undef PG8_STAGE
#undef PG8_LDA
#undef PG8_LDB
#undef PG8_MMA
#undef PG8_CAT
#undef PG8_WAIT_V
#undef PG8_WAIT_L
#undef PG8_BAR
#undef PG8_SCHED
#undef PG8_VOFFS
}
}

namespace att {
constexpr int SLOTB = 65536, K_OFF = 0, V_OFF = 32768;
__device__ __forceinline__ void glds16s(unsigned voff, const void* sbase, unsigned lds_dst) { unsigned keep;
    asm volatile("s_mov_b32 %0, m0\n\ts_mov_b32 m0, %3\n\ts_nop 0\n\tglobal_load_lds_dwordx4 %1, %2\n\ts_mov_b32 m0, %0" : "=&s"(keep) : "v"(voff), "s"(sbase), "s"(lds_dst) : "memory"); }
__device__ __forceinline__ void glds16s_nc(unsigned voff, const void* sbase, unsigned lds_dst) { unsigned keep;
    asm volatile("s_mov_b32 %0, m0\n\ts_mov_b32 m0, %3\n\ts_nop 0\n\tglobal_load_lds_dwordx4 %1, %2\n\ts_mov_b32 m0, %0" : "=&s"(keep) : "v"(voff), "s"(sbase), "s"(lds_dst)); }
typedef short v4i16_t __attribute__((ext_vector_type(4)));
__device__ __forceinline__ s16x4 vtr(const LAS unsigned char* p) { return __builtin_bit_cast(s16x4, __builtin_amdgcn_ds_read_tr16_b64_v4i16((LAS v4i16_t*)p)); }
#define ATT_WAIT_BAR() asm volatile("s_waitcnt vmcnt(0) lgkmcnt(0)\n\ts_barrier" ::: "memory")

#define ATT_SB() __builtin_amdgcn_sched_barrier(0)
__device__ __forceinline__ void rowbuf_put(LAS unsigned char* buf, int fr, int fq, int qh, int db, u32x2 w) {
    const int row = 16 * qh + fr; *(LAS u32x2*)(buf + row * 512 + (((2 * db + (fq >> 1)) ^ (row & 15)) << 4) + (fq & 1) * 8) = w; }
template <int NROWS>
__device__ __forceinline__ void rowbuf_store(const LAS unsigned char* buf, int lane, bf16_t* gdst, int pitch) {
    asm volatile("s_waitcnt lgkmcnt(0)" ::: "memory");
    bf16_t* dst = gdst + (size_t)(lane >> 5) * pitch + (lane & 31) * 8;
#pragma unroll
    for (int i = 0; i < NROWS / 2; ++i) { const int row = 2 * i + (lane >> 5);
        const u32x4 v = *(const LAS u32x4*)(buf + row * 512 + (((lane & 31) ^ (row & 15)) << 4)); *(u32x4*)(dst + (size_t)(2 * i) * pitch) = v; }
}

__device__ __forceinline__ void attn_core16(f32x4 (&O)[16][2], float (&lq)[2], const bf16_t* Qw, int q_pitch, const bf16_t* Kh, const bf16_t* Vh, int kv_pitch,
                                            int NT, int nt_act, int kch0, float negb, LAS unsigned char* ring, int wid) {
    int lane = (int)__builtin_amdgcn_mbcnt_hi(~0u, __builtin_amdgcn_mbcnt_lo(~0u, 0u)); asm volatile("" : "+v"(lane));
    const int fr = lane & 15, fq = lane >> 4;
    const unsigned lds0 = (unsigned)(uintptr_t)ring;
    const int prow = lane >> 3;
    const int kq = (lane & 7) ^ ((4 * (wid & 1) + (lane >> 4)) & 7);
    const int vq = (lane & 7) ^ (((prow >> 1) & 3) << 1);
    const unsigned koff = (unsigned)((8 * wid + prow) * kv_pitch + kq * 8) * 2u, voff = (unsigned)((8 * wid + prow) * kv_pitch + vq * 8) * 2u;
#define A16_DMA_K(t, slot) do { const bf16_t* ks_ = Kh + (size_t)(t) * 64 * kv_pitch; const unsigned kd_ = (unsigned)__builtin_amdgcn_readfirstlane(lds0 + (slot) * SLOTB + K_OFF + wid * 4096); \
        _Pragma("unroll") for (int j_ = 0; j_ < 4; ++j_) glds16s(koff, ks_ + j_ * 64, kd_ + j_ * 1024); } while (0)
#define A16_DMA_V(t, slot) do { const bf16_t* vs_ = Vh + (size_t)(t) * 64 * kv_pitch; const unsigned vd_ = (unsigned)__builtin_amdgcn_readfirstlane(lds0 + (slot) * SLOTB + V_OFF + wid * 4096); \
        _Pragma("unroll") for (int j_ = 0; j_ < 4; ++j_) glds16s(voff, vs_ + j_ * 64, vd_ + j_ * 1024); } while (0)
#define A16_DMA_K1(t, slot, j) glds16s_nc(koff, Kh + (size_t)(t) * 64 * kv_pitch + (j) * 64, (unsigned)__builtin_amdgcn_readfirstlane(lds0 + (slot) * SLOTB + K_OFF + wid * 4096 + (j) * 1024))
#define A16_DMA_V1(t, slot, j) glds16s_nc(voff, Vh + (size_t)(t) * 64 * kv_pitch + (j) * 64, (unsigned)__builtin_amdgcn_readfirstlane(lds0 + (slot) * SLOTB + V_OFF + wid * 4096 + (j) * 1024))
    A16_DMA_K(0, 0); A16_DMA_V(0, 0);
    if (NT > 1) A16_DMA_K(1, 1);
    bf16x8 qr[2][4];
    const bf16_t* qp = Qw + (size_t)fr * q_pitch + fq * 8;
#pragma unroll
    for (int qh = 0; qh < 2; ++qh)
#pragma unroll
        for (int d = 0; d < 4; ++d) qr[qh][d] = *(const bf16x8*)(qp + (size_t)(qh * 16) * q_pitch + d * 32);
    const f32x4 z4 = {0.f, 0.f, 0.f, 0.f};
#pragma unroll
    for (int db = 0; db < 16; ++db) { O[db][0] = z4; O[db][1] = z4; }
    float l0 = 0.f, l1 = 0.f;
    const int ksw = (fr >> 1) & 7;
    const LAS unsigned char* kb0 = ring + K_OFF + (kch0 >> 3) * 1024 + (fr >> 3) * 4096 + (fr & 7) * 128;
    const LAS unsigned char* kbp[2] = {kb0 + ((0 + fq) ^ ksw) * 16, kb0 + ((4 + fq) ^ ksw) * 16};
    const int vsw = ((2 * (fq & 1) + (fr >> 3)) & 3) << 1;
    const LAS unsigned char* vb0 = ring + V_OFF + (fq >> 1) * 4096 + (4 * (fq & 1) + (fr >> 2)) * 128 + ((fr & 3) >> 1) * 16 + (fr & 1) * 8;
    const LAS unsigned char* vbp[4] = {vb0 + ((0 ^ vsw) << 4), vb0 + ((2 ^ vsw) << 4), vb0 + ((4 ^ vsw) << 4), vb0 + ((6 ^ vsw) << 4)};
    f32x4 S[4][2]; u32x4 pw[2][2];
    f32x4 nb4 = {negb, negb, negb, negb}; asm volatile("" : "+v"(nb4));
#define A16_KF(kb, ds) (*(const LAS bf16x8*)(kbp[(ds) & 1] + so_ + (kb) * 8192 + ((ds) >> 1) * 1024))
#define A16_QK(tt, DMAI, td) do { const int so_ = ((tt) & 1) * SLOTB; const int tk_ = ((td) + 2 < NT) ? (td) + 2 : NT - 1, tv_ = ((td) + 1 < NT) ? (td) + 1 : NT - 1; (void)tk_; (void)tv_; \
        bf16x8 kf_[3]; kf_[0] = A16_KF(0, 0); kf_[1] = A16_KF(1, 0); \
        ATT_SB(); \
        _Pragma("unroll") for (int g_ = 0; g_ < 16; ++g_) { const int ds_ = g_ >> 2, kb_ = g_ & 3; \
            if (g_ + 2 < 16) kf_[(g_ + 2) % 3] = A16_KF((g_ + 2) & 3, (g_ + 2) >> 2); \
            S[kb_][0] = __builtin_amdgcn_mfma_f32_16x16x32_bf16(kf_[g_ % 3], qr[0][ds_], (ds_ == 0) ? nb4 : S[kb_][0], 0, 0, 0); \
            S[kb_][1] = __builtin_amdgcn_mfma_f32_16x16x32_bf16(kf_[g_ % 3], qr[1][ds_], (ds_ == 0) ? nb4 : S[kb_][1], 0, 0, 0); \
            if ((DMAI) && g_ < 8) { if (g_ < 4) A16_DMA_K1(tk_, (td) & 1, g_); else A16_DMA_V1(tv_, ((td) + 1) & 1, g_ - 4); } \
            ATT_SB(); } } while (0)
#define A16_EL(i) S[(i) >> 3][((i) >> 2) & 1][(i) & 3]
#define A16_PACK() do { _Pragma("unroll") for (int p_ = 0; p_ < 2; ++p_) _Pragma("unroll") for (int h_ = 0; h_ < 2; ++h_) \
        pw[p_][h_] = (u32x4){pk2(S[2 * p_][h_][0], S[2 * p_][h_][1]), pk2(S[2 * p_][h_][2], S[2 * p_][h_][3]), pk2(S[2 * p_ + 1][h_][0], S[2 * p_ + 1][h_][1]), pk2(S[2 * p_ + 1][h_][2], S[2 * p_ + 1][h_][3])}; } while (0)
    ATT_WAIT_BAR();
#pragma unroll
    for (int qh = 0; qh < 2; ++qh)
#pragma unroll
        for (int d = 0; d < 4; ++d) asm volatile("" : "+v"(qr[qh][d]));
    {
        A16_QK(0, 0, 0);
        float s0 = 0.f, s1 = 0.f;
#pragma unroll
        for (int i = 0; i < 32; ++i) { A16_EL(i) = __builtin_amdgcn_exp2f(A16_EL(i)); if ((i >> 2) & 1) s1 += A16_EL(i); else s0 += A16_EL(i); }
        l0 += s0; l1 += s1;
        A16_PACK();
    }
#pragma unroll 1
    for (int t = 0; t < NT; ++t) {
        ATT_WAIT_BAR();
        if (t < nt_act) {
            const bool more = (t + 1 < nt_act);
            const int vso = (t & 1) * SLOTB;
            s16x4 vv[3][2];
#define A16_VLD(v, g) do { const LAS unsigned char* a_ = vbp[(g) & 3] + vso + ((g) >> 4) * 16384 + (((g) & 15) >> 2) * 1024; v[0] = vtr(a_); v[1] = vtr(a_ + 8192); } while (0)
#define A16_VF(v) (bf16x8){v[0][0], v[0][1], v[0][2], v[0][3], v[1][0], v[1][1], v[1][2], v[1][3]}
            A16_VLD(vv[0], 0);
            ATT_SB();
            A16_QK(t + 1, 1, t);
            ATT_SB();
            A16_VLD(vv[1], 1);
            float s0 = 0.f, s1 = 0.f;
#define A16_GAP(i) do { A16_EL(i) = __builtin_amdgcn_exp2f(A16_EL(i)); \
                if ((i) > 0) { if ((((i) - 1) >> 2) & 1) s1 += A16_EL((i) - 1); else s0 += A16_EL((i) - 1); } asm volatile("" : "+v"(s0), "+v"(s1)); } while (0)
#pragma unroll
            for (int g = 0; g < 32; ++g) {
                if (g + 2 < 32) A16_VLD(vv[(g + 2) % 3], g + 2);
                ATT_SB();
                O[g & 15][0] = __builtin_amdgcn_mfma_f32_16x16x32_bf16(A16_VF(vv[g % 3]), __builtin_bit_cast(bf16x8, pw[g >> 4][0]), O[g & 15][0], 0, 0, 0);
                O[g & 15][1] = __builtin_amdgcn_mfma_f32_16x16x32_bf16(A16_VF(vv[g % 3]), __builtin_bit_cast(bf16x8, pw[g >> 4][1]), O[g & 15][1], 0, 0, 0);
                A16_GAP(g);
                ATT_SB();
            }
#undef A16_VLD
#undef A16_VF
#undef A16_GAP
            l0 += more ? s0 : 0.f; l1 += more ? (s1 + A16_EL(31)) : 0.f;
            A16_PACK();
        }
    }
    ATT_WAIT_BAR();
    l0 += sx<16>(l0); l1 += sx<16>(l1);
    lq[0] = sum32x(l0); lq[1] = sum32x(l1);
#undef A16_DMA_K
#undef A16_DMA_V
#undef A16_DMA_K1
#undef A16_DMA_V1
#undef A16_QK
#undef A16_KF
#undef A16_EL
#undef A16_PACK
}

__device__ __forceinline__ void mem_attn_core16(const bf16_t* Qw, int q_pitch, const bf16_t* Kh, const bf16_t* Vh, int kv_pitch, float negb, LAS unsigned char* ring, int wid, bf16_t* Yw, int y_pitch) {
    int lane = (int)__builtin_amdgcn_mbcnt_hi(~0u, __builtin_amdgcn_mbcnt_lo(~0u, 0u)); asm volatile("" : "+v"(lane));
    const int fr = lane & 15, fq = lane >> 4;
    const unsigned lds0 = (unsigned)(uintptr_t)ring;
    const int prow = lane >> 3;
    const int kq = (lane & 7) ^ ((4 * (wid & 1) + (lane >> 4)) & 7);
    const int vq = (lane & 7) ^ (((prow >> 1) & 3) << 1);
    const unsigned koff = (unsigned)((8 * wid + prow) * kv_pitch + kq * 8) * 2u, voff = (unsigned)((8 * wid + prow) * kv_pitch + vq * 8) * 2u;
    const unsigned dst0 = (unsigned)__builtin_amdgcn_readfirstlane(lds0 + wid * 4096);
#pragma unroll
    for (int t = 0; t < 4; ++t)
#pragma unroll
        for (int j = 0; j < 4; ++j) glds16s(koff, Kh + (size_t)t * 64 * kv_pitch + j * 64, dst0 + t * 32768 + j * 1024);
    const bf16_t* qp = Qw + (size_t)fr * q_pitch + fq * 8;
    const int ksw = (fr >> 1) & 7;
    const LAS unsigned char* kb0 = ring + (fr >> 3) * 4096 + (fr & 7) * 128;
    const LAS unsigned char* kbp[2] = {kb0 + ((0 + fq) ^ ksw) * 16, kb0 + ((4 + fq) ^ ksw) * 16};
    asm volatile("s_waitcnt vmcnt(0) lgkmcnt(0)\n\ts_barrier" ::: "memory");
    f32x4 S[4][4][2];
    const f32x4 z4 = {0.f, 0.f, 0.f, 0.f};
#pragma unroll
    for (int hf = 0; hf < 2; ++hf) {
        bf16x8 qr[2][4];
#pragma unroll
        for (int qh = 0; qh < 2; ++qh)
#pragma unroll
            for (int d = 0; d < 4; ++d) qr[qh][d] = *(const bf16x8*)(qp + (size_t)(qh * 16) * q_pitch + (hf * 4 + d) * 32);
#pragma unroll
        for (int t = 0; t < 4; ++t)
#pragma unroll
            for (int kb = 0; kb < 4; ++kb)
#pragma unroll
                for (int d = 0; d < 4; ++d) { const int ds = hf * 4 + d;
                    const bf16x8 kf = *(const LAS bf16x8*)(kbp[ds & 1] + t * 32768 + kb * 8192 + (ds >> 1) * 1024);
#pragma unroll
                    for (int qh = 0; qh < 2; ++qh) S[t][kb][qh] = __builtin_amdgcn_mfma_f32_16x16x32_bf16(kf, qr[qh][d], (ds == 0) ? z4 : S[t][kb][qh], 0, 0, 0);
                    if (d & 1) __builtin_amdgcn_sched_barrier(0); }
    }
    asm volatile("s_waitcnt lgkmcnt(0)\n\ts_barrier" ::: "memory");
#pragma unroll
    for (int t = 0; t < 4; ++t)
#pragma unroll
        for (int j = 0; j < 4; ++j) glds16s(voff, Vh + (size_t)t * 64 * kv_pitch + j * 64, dst0 + t * 32768 + j * 1024);
    float l[2] = {0.f, 0.f}; u32x4 pw[4][2][2];
#pragma unroll
    for (int t = 0; t < 4; ++t)
#pragma unroll
        for (int p = 0; p < 2; ++p)
#pragma unroll
            for (int qh = 0; qh < 2; ++qh) { f32x4 a = S[t][2 * p][qh], b = S[t][2 * p + 1][qh];
#pragma unroll
                for (int e = 0; e < 4; ++e) { a[e] = __builtin_amdgcn_exp2f(a[e] + negb); b[e] = __builtin_amdgcn_exp2f(b[e] + negb); }
                l[qh] += ((a[0] + a[1]) + (a[2] + a[3])) + ((b[0] + b[1]) + (b[2] + b[3])); asm volatile("" : "+v"(l[qh]));
                pw[t][p][qh] = (u32x4){pk2(a[0], a[1]), pk2(a[2], a[3]), pk2(b[0], b[1]), pk2(b[2], b[3])};
                __builtin_amdgcn_sched_barrier(0); }
    const int vsw = ((2 * (fq & 1) + (fr >> 3)) & 3) << 1;
    const LAS unsigned char* vb0 = ring + (fq >> 1) * 4096 + (4 * (fq & 1) + (fr >> 2)) * 128 + ((fr & 3) >> 1) * 16 + (fr & 1) * 8;
    const LAS unsigned char* vbp[4] = {vb0 + ((0 ^ vsw) << 4), vb0 + ((2 ^ vsw) << 4), vb0 + ((4 ^ vsw) << 4), vb0 + ((6 ^ vsw) << 4)};
    asm volatile("s_waitcnt vmcnt(0) lgkmcnt(0)\n\ts_barrier" ::: "memory");
    f32x4 O[16][2];
#pragma unroll
    for (int t = 0; t < 4; ++t)
#pragma unroll
        for (int p = 0; p < 2; ++p)
#pragma unroll
            for (int db = 0; db < 16; ++db) {
                const LAS unsigned char* va = vbp[db & 3] + t * 32768 + p * 16384 + (db >> 2) * 1024;
                const s16x4 lo = vtr(va), hh = vtr(va + 8192);
                const bf16x8 vf = (bf16x8){lo[0], lo[1], lo[2], lo[3], hh[0], hh[1], hh[2], hh[3]};
#pragma unroll
                for (int qh = 0; qh < 2; ++qh) O[db][qh] = __builtin_amdgcn_mfma_f32_16x16x32_bf16(vf, __builtin_bit_cast(bf16x8, pw[t][p][qh]), (t == 0 && p == 0) ? z4 : O[db][qh], 0, 0, 0);
                if (db & 1) __builtin_amdgcn_sched_barrier(0); }
    asm volatile("s_waitcnt lgkmcnt(0)\n\ts_barrier" ::: "memory");
    LAS unsigned char* rb = ring + wid * 16384;
#pragma unroll
    for (int qh = 0; qh < 2; ++qh) { float ls = l[qh]; ls += sx<16>(ls); ls = sum32x(ls);
        const float inv = __builtin_amdgcn_rcpf(ls);
#pragma unroll
        for (int db = 0; db < 16; ++db) { const f32x4 v = O[db][qh] * inv; u32x2 w; w.x = pk2(v[0], v[1]); w.y = pk2(v[2], v[3]); rowbuf_put(rb, fr, fq, qh, db, w); } }
    rowbuf_store<32>(rb, lane, Yw, y_pitch);
}
}

#define XB_TMO      128
#define XB_XCNT(j)  (256  + 64 * (j))
#define XB_XSUB(j)  (1280 + 64 * (j))
#define XB_XGEN(j)  (2304 + 64 * (j))
#define XB_TOP      3328
#define XB_TOPGEN   3392
#define XCD_BAR_WORDS 3456
#define XB_SPIN_CAP (1u << 22)

__device__ __forceinline__ unsigned xb_ld(unsigned* p)              { return __hip_atomic_load(p, __ATOMIC_RELAXED, __HIP_MEMORY_SCOPE_AGENT); }
__device__ __forceinline__ unsigned xb_add(unsigned* p, unsigned v) { return __hip_atomic_fetch_add(p, v, __ATOMIC_RELAXED, __HIP_MEMORY_SCOPE_AGENT); }
__device__ __forceinline__ unsigned xb_xcc_id() { return (unsigned)__builtin_amdgcn_s_getreg((3 << 11) | 20) & 0xFu; }
#define XB_SPIN(cond, bar) do { unsigned _sp = 0; while (cond) { __builtin_amdgcn_s_sleep(1); \
    if ((++_sp & 255u) == 0u) { if (xb_ld(&(bar)[XB_TMO])) break; if (_sp > XB_SPIN_CAP) { atomicAdd(&(bar)[XB_TMO], 1u); break; } } } } while (0)

struct XcdBarrier { unsigned* bar; unsigned x; volatile LAS unsigned* st; };

__device__ __forceinline__ XcdBarrier xcd_barrier_post(unsigned* bar, volatile LAS unsigned* st) {
    XcdBarrier b; b.bar = bar; b.x = xb_xcc_id(); b.st = st;
    if (threadIdx.x == 0) (void)xb_add(&bar[XB_XCNT(b.x)], 1u);
    return b;
}
__device__ __forceinline__ bool xb_leader(int wave) { return wave == 0 && __builtin_amdgcn_mbcnt_hi(~0u, __builtin_amdgcn_mbcnt_lo(~0u, 0u)) == 0u; }
__device__ __forceinline__ void xcd_barrier_complete(unsigned* bar, unsigned x, unsigned& nloc, unsigned& nx) {
    const unsigned G = gridDim.x * gridDim.y * gridDim.z;
    unsigned sum, cnt, mine, sp = 0u;
    for (;;) {
        sum = 0u; cnt = 0u; mine = 0u;
#pragma unroll
        for (unsigned j = 0; j < 16; ++j) { const unsigned c = xb_ld(&bar[XB_XCNT(j)]); sum += c; cnt += (c > 0u) ? 1u : 0u; mine = (j == x) ? c : mine; }
        if (sum == G) break;
        __builtin_amdgcn_s_sleep(1);
        if ((++sp & 255u) == 0u) { if (xb_ld(&bar[XB_TMO])) break; if (sp > XB_SPIN_CAP) { atomicAdd(&bar[XB_TMO], 1u); break; } }
    }
    nloc = mine > 0u ? mine : 1u; nx = cnt > 0u ? cnt : 1u;
}
__device__ __forceinline__ void xcd_barrier(const XcdBarrier& b, const int wave) {
    asm volatile("s_waitcnt vmcnt(0)" ::: "memory");
    __syncthreads();
    if (xb_leader(wave)) {
        unsigned* bar = b.bar;
        __builtin_amdgcn_s_waitcnt(0);
        unsigned nloc = b.st[0], nx = b.st[1];
        if (nloc == 0u) { xcd_barrier_complete(bar, b.x, nloc, nx); b.st[0] = nloc; b.st[1] = nx; }
        const unsigned old = xb_add(&bar[XB_XSUB(b.x)], 1u);
        const unsigned gen = old / nloc;
        if (old + 1u == (gen + 1u) * nloc) {
            __builtin_amdgcn_fence(__ATOMIC_RELEASE, "agent");
            asm volatile("s_waitcnt vmcnt(0)" ::: "memory");
            const unsigned og = xb_add(&bar[XB_TOP], 1u);
            const unsigned tg = og / nx;
            if (og + 1u == (tg + 1u) * nx) xb_add(&bar[XB_TOPGEN], 1u);
            else XB_SPIN(xb_ld(&bar[XB_TOPGEN]) == tg, bar);
            __builtin_amdgcn_fence(__ATOMIC_ACQUIRE, "agent");
            xb_add(&bar[XB_XGEN(b.x)], 1u);
            asm volatile("s_waitcnt vmcnt(0)" ::: "memory");
        } else {
            XB_SPIN(xb_ld(&bar[XB_XGEN(b.x)]) == gen, bar);
            __builtin_amdgcn_fence(__ATOMIC_ACQUIRE, "agent");
            asm volatile("s_waitcnt vmcnt(0)" ::: "memory");
        }
    }
    __syncthreads();
}

template <bool NTS = false>
__device__ __forceinline__ void transpose_item(const float* W, int N, int k0, int nsrc0, bf16_t* WT, int ldt, int ndst0, LAS float* scr, int lane, const float* kscale = nullptr) {
    float wv[32];
#pragma unroll
    for (int i = 0; i < 32; ++i) wv[i] = __builtin_nontemporal_load(&W[(size_t)(k0 + 2 * i + (lane >> 5)) * N + nsrc0 + (lane & 31)]);
#pragma unroll
    for (int i = 0; i < 32; ++i) { const int kk = 2 * i + (lane >> 5); const float sc = kscale ? kscale[k0 + kk] : 1.0f; scr[kk * 33 + (lane & 31)] = wv[i] * sc; }
    LDS_WAIT(); asm volatile("" ::: "memory");
    const int c = lane & 7;
#pragma unroll
    for (int j = 0; j < 4; ++j) { const int n = (lane >> 3) + 8 * j; const LAS float* s = scr + (8 * c) * 33 + n;
        u32x4 o; o.x = pk2(s[0 * 33], s[1 * 33]); o.y = pk2(s[2 * 33], s[3 * 33]); o.z = pk2(s[4 * 33], s[5 * 33]); o.w = pk2(s[6 * 33], s[7 * 33]);
        if (NTS) __builtin_nontemporal_store(o, (GAS u32x4*)(WT + (size_t)(ndst0 + n) * ldt + k0 + 8 * c)); else *(GAS u32x4*)(WT + (size_t)(ndst0 + n) * ldt + k0 + 8 * c) = o; }
    LDS_WAIT(); asm volatile("" ::: "memory");
}
__device__ __forceinline__ void transpose_item_fp8(const float* W, int N, int k0, int nsrc0, unsigned char* WT8, int ldt, int ndst0, LAS float* scr, int lane, float scale) {
    float wv[32];
#pragma unroll
    for (int i = 0; i < 32; ++i) wv[i] = __builtin_nontemporal_load(&W[(size_t)(k0 + 2 * i + (lane >> 5)) * N + nsrc0 + (lane & 31)]);
#pragma unroll
    for (int i = 0; i < 32; ++i) { const int kk = 2 * i + (lane >> 5); scr[kk * 33 + (lane & 31)] = wv[i] * scale; }
    LDS_WAIT(); asm volatile("" ::: "memory");
    const int c = lane & 7;
#pragma unroll
    for (int j = 0; j < 4; ++j) { const int n = (lane >> 3) + 8 * j; const LAS float* s = scr + (8 * c) * 33 + n;
        u32x2 o; o.x = pk4_fp8(s[0 * 33], s[1 * 33], s[2 * 33], s[3 * 33]); o.y = pk4_fp8(s[4 * 33], s[5 * 33], s[6 * 33], s[7 * 33]);
        *(GAS u32x2*)(WT8 + (size_t)(ndst0 + n) * ldt + k0 + 8 * c) = o; }
    LDS_WAIT(); asm volatile("" ::: "memory");
}
template <bool NTS = false>
__device__ __forceinline__ void tr_plain(const float* W, int K, int N, bf16_t* WT, LAS float* scr, int r, int lane) {
    const int nblk = N / 32, kb = r / nblk, nb = r % nblk;
    transpose_item<NTS>(W, N, 64 * kb, 32 * nb, WT, K, 32 * nb, scr, lane);
}
__device__ __forceinline__ void rms_row_4096(const float* xrow, const float* g, bf16_t* orow, int lane, unsigned char* qrow = nullptr, float* rs_out = nullptr) {
    const GAS f32x4* xr = (const GAS f32x4*)xrow + lane; const GAS f32x4* gr = (const GAS f32x4*)g + lane;
    f32x4 v[16]; float s = 0.f;
#pragma unroll
    for (int j = 0; j < 16; ++j) { v[j] = __builtin_nontemporal_load(xr + 64 * j); s += (v[j].x * v[j].x + v[j].y * v[j].y) + (v[j].z * v[j].z + v[j].w * v[j].w); }
    const float rstd = 1.f / sqrtf(wave_sum(s) * (1.f / 4096.f) + EPS);
    if (rs_out != nullptr && lane == 0) *rs_out = rstd;
    GAS u32x2* o8 = (GAS u32x2*)orow + lane;
#pragma unroll
    for (int j = 0; j < 16; ++j) { const f32x4 gg = gr[64 * j]; const float y0 = v[j].x * rstd * gg.x, y1 = v[j].y * rstd * gg.y, y2 = v[j].z * rstd * gg.z, y3 = v[j].w * rstd * gg.w;
        u32x2 w; if (rs_out != nullptr) { w.x = pk2(v[j].x, v[j].y); w.y = pk2(v[j].z, v[j].w); } else { w.x = pk2(y0, y1); w.y = pk2(y2, y3); }
        o8[64 * j] = w;
        if (qrow) ((GAS unsigned*)qrow + lane)[64 * j] = pk4_fp8(y0, y1, y2, y3); }
}
__constant__ float ROPE_INV2PI[16] = {1.5915494309e-01f, 7.0086521588e-02f, 3.0863763405e-02f, 1.3591370636e-02f, 5.9851857127e-03f, 2.6356758987e-03f, 1.1606636412e-03f, 5.1111750454e-04f,
                                      2.2507907904e-04f, 9.9117309369e-05f, 4.3647952793e-05f, 1.9221100685e-05f, 8.4643308082e-06f, 3.7274086019e-06f, 1.6414262628e-06f, 7.2282930688e-07f};
template <int W>
__device__ __forceinline__ void pool_prep_seg(const bf16_t* src, bf16_t* dst, int t0) {
    u32x4 wv[W - 1 + 16];
#pragma unroll
    for (int k = 0; k < W - 1 + 16; ++k) { const int rel = k - (W - 1); wv[k] = (rel >= 0 || t0 > 0) ? *(const u32x4*)(src + (ptrdiff_t)rel * 1024) : (u32x4){0u, 0u, 0u, 0u}; }
    float sm[8];
#pragma unroll
    for (int e = 0; e < 8; ++e) sm[e] = 0.f;
#pragma unroll
    for (int k = 0; k < W - 1; ++k) { float f[8]; unpack8(wv[k], f);
#pragma unroll
        for (int e = 0; e < 8; ++e) sm[e] += f[e]; }
#pragma unroll
    for (int j = 0; j < 16; ++j) { float cur[8], f[8]; unpack8(wv[W - 1 + j], cur);
#pragma unroll
        for (int e = 0; e < 8; ++e) sm[e] += cur[e];
        const int n = (t0 > 0 || j + 1 >= W) ? W : j + 1; const float inv = 1.0f / (float)n;
        u32x4 o; o.x = pk2(sm[0] * inv - cur[0], sm[1] * inv - cur[1]); o.y = pk2(sm[2] * inv - cur[2], sm[3] * inv - cur[3]);
        o.z = pk2(sm[4] * inv - cur[4], sm[5] * inv - cur[5]); o.w = pk2(sm[6] * inv - cur[6], sm[7] * inv - cur[7]);
        *(u32x4*)(dst + (size_t)j * 1024) = o;
        unpack8(wv[j], f);
#pragma unroll
        for (int e = 0; e < 8; ++e) sm[e] -= f[e]; }
}

struct Args { const float* in[26]; float* out; unsigned char* ws; };

__global__ void __launch_bounds__(NWAVES * 64, 2) mk_fwd(Args args) {
    extern __shared__ __attribute__((aligned(16))) unsigned char lds_raw[];
    LAS unsigned char* lds = (LAS unsigned char*)lds_raw;
    volatile LAS unsigned* MISC = (volatile LAS unsigned*)(lds + MISC_OFF);
    const int wave = __builtin_amdgcn_readfirstlane(threadIdx.x >> 6);
#define PHASE_IDS() int lane = (int)__builtin_amdgcn_mbcnt_hi(~0u, __builtin_amdgcn_mbcnt_lo(~0u, 0u)); asm volatile("" : "+v"(lane)); const int tid = wave * 64 + lane; const int gw = vcu * NWAVES + wave, NGW = G * NWAVES; (void)tid; (void)gw; (void)NGW
    const int G = gridDim.x; const int bx = blockIdx.x; const int vcu = (G % 8 == 0) ? (bx % 8) * (G / 8) + bx / 8 : bx;
    unsigned char* ws = args.ws;
    unsigned* ctl = (unsigned*)(ws + WS_CTL);
    const float* x = args.in[0]; const float* mem = args.in[1]; const float* g_attn = args.in[2]; const float* w_in = args.in[3];
    const float* g_qa = args.in[4]; const float* g_ka = args.in[5]; const float* lam_q1 = args.in[6]; const float* lam_k1 = args.in[7];
    const float* lam_q2 = args.in[8]; const float* lam_k2 = args.in[9]; const float* g_subln = args.in[10]; const float* w_pool = args.in[11];
    const float* pool_scale = args.in[12]; const float* g_mem = args.in[13]; const float* w_mkv = args.in[14]; const float* g_qm = args.in[15];
    const float* g_km = args.in[16]; const float* w_a = args.in[17]; const float* w_b = args.in[18]; const float* w_c = args.in[19];
    const float* w_o = args.in[20]; const float* g_ffn = args.in[21]; const float* w_up = args.in[22]; const float* conv_w = args.in[23];
    const float* conv_b = args.in[24]; const float* w_down = args.in[25];
    float* out = args.out;
    unsigned char* WG8 = ws + WS_WG8; unsigned char* H8 = (unsigned char*)out + DO_H8;
    bf16_t* W_UP = (bf16_t*)(ws + WS_WUP); bf16_t* W_DOWN = (bf16_t*)(ws + WS_WDOWN); bf16_t* W_IN = (bf16_t*)(ws + WS_WIN);
    bf16_t* W_A = (bf16_t*)(ws + WS_WA); bf16_t* W_B = (bf16_t*)(ws + WS_WB); bf16_t* W_C = (bf16_t*)(ws + WS_WC); bf16_t* W_O = (bf16_t*)(ws + WS_WO);
    bf16_t* W_MKV = (bf16_t*)(ws + WS_WMKV);
    bf16_t* KVM = (bf16_t*)(ws + WS_KVM); bf16_t* HM = (bf16_t*)(ws + WS_HM);
    bf16_t* QA = (bf16_t*)(ws + WS_QA); bf16_t* KA = (bf16_t*)(ws + WS_KA); bf16_t* VA = (bf16_t*)(ws + WS_VA);
    bf16_t* UPB = (bf16_t*)(ws + WS_UP); bf16_t* QM = (bf16_t*)(ws + WS_QM); unsigned char* GL = ws + WS_GL; bf16_t* YP = (bf16_t*)(ws + WS_YP);
    bf16_t* MERGED = (bf16_t*)(ws + WS_MERGED); bf16_t* X1B = (bf16_t*)(ws + WS_X1B); bf16_t* ACT = (bf16_t*)(ws + WS_ACT); float* SSQ = (float*)(ws + WS_SSQ); float* HALO = (float*)(ws + WS_HALO);
    bf16_t* XB = (bf16_t*)out; float* RS1 = (float*)(ws + WS_RS1); bf16_t* YA = (bf16_t*)((unsigned char*)out + DO_YA); bf16_t* YC = (bf16_t*)((unsigned char*)out + DO_YC);

    for (int u = threadIdx.x; u < (LDS_BYTES - LDSCTL_OFF) / 4; u += NWAVES * 64) ((LAS unsigned*)(lds + LDSCTL_OFF))[u] = 0u;
    __syncthreads();
    XcdBarrier bar = xcd_barrier_post(ctl + CW_BAR, MISC + 8);

    {
        PHASE_IDS();
        LAS float* scr = (LAS float*)(lds + RING_OFF + wave * 16384);
        for (int it = gw; it < 64 * 64; it += NGW) tr_plain(w_mkv, 4096, 2048, W_MKV, scr, it, lane);
        for (int m = gw; m < MROWS; m += NGW) rms_row_4096(mem + (size_t)m * DMODEL, g_mem, HM + (size_t)m * DMODEL, lane);
    }
    constexpr int MKV_CUS = 16;
    const bool p0_split = (G > 2 * MKV_CUS);
    if (p0_split) {
        asm volatile("s_waitcnt vmcnt(0)" ::: "memory");
        __syncthreads();
        if (xb_leader(wave)) { __builtin_amdgcn_fence(__ATOMIC_RELEASE, "agent"); asm volatile("s_waitcnt vmcnt(0)" ::: "memory"); (void)xb_add(ctl + CW_P0A, 1u); }
    } else xcd_barrier(bar, wave);
    if (vcu < MKV_CUS && p0_split) {
        if (xb_leader(wave)) { XB_SPIN(xb_ld(ctl + CW_P0A) != (unsigned)G, ctl + CW_BAR); __builtin_amdgcn_fence(__ATOMIC_ACQUIRE, "agent"); asm volatile("s_waitcnt vmcnt(0)" ::: "memory"); }
        __syncthreads();
        struct OneUnit { int id; __device__ __forceinline__ bool next(int i, pg8::Unit& u) const { if (i != 0) return false; u.pm = id >> 3; u.pn = id & 7; return true; } };
        pg8::Gemm1 g{HM, W_MKV, DMODEL, DMODEL, DMODEL, 0}; OneUnit S{vcu};
        pg8::EpiKvm E{KVM, g_km, (LAS float*)(lds + XCH_OFF)};
        pg8::gemm_phase<pg8::EpiKvm, OneUnit, pg8::Gemm1>(lds + RING_OFF, g, S, E, wave);
        {
            PHASE_IDS();
            LAS float* scr = (LAS float*)(lds + RING_OFF + wave * 16384);
            for (int it = wave; it < 128; it += NWAVES) { const int kb = it >> 3, nb = it & 7;
                transpose_item(w_b, 4096, 64 * kb, 256 * vcu + 32 * nb, W_B, 1024, 256 * vcu + 32 * nb, scr, lane, pool_scale); }
            bf16_t* WPc = (bf16_t*)(ws + WS_WPF) + (size_t)vcu * (1024 * 256);
#pragma unroll 1
            for (int r0 = wave * 128; r0 < wave * 128 + 128; r0 += 16) { f32x4 v[16];
#pragma unroll
                for (int j = 0; j < 16; ++j) v[j] = __builtin_nontemporal_load((const f32x4*)(w_pool + (size_t)(r0 + j) * 256 + 4 * lane));
#pragma unroll
                for (int j = 0; j < 16; ++j) { u32x2 w; w.x = pk2(v[j][0], v[j][1]); w.y = pk2(v[j][2], v[j][3]); *(u32x2*)(WPc + (size_t)(r0 + j) * 256 + 4 * lane) = w; } }
            asm volatile("s_waitcnt vmcnt(0)" ::: "memory");
            __syncthreads();
            if (xb_leader(wave)) { __builtin_amdgcn_fence(__ATOMIC_ACQ_REL, "agent"); asm volatile("s_waitcnt vmcnt(0)" ::: "memory"); }
            __syncthreads();
            struct FoldUnits { int pm; __device__ __forceinline__ bool next(int i, pg8::Unit& u) const { if (i >= 4) return false; u.pm = pm; u.pn = i; return true; } };
            pg8::Gemm1 gf{W_B, WPc, 1024, 256, 256, 256}; FoldUnits Sf{vcu};
            pg8::EpiBf16 Ef{(bf16_t*)(ws + WS_WBF), 1024, nullptr};
            pg8::gemm_phase<pg8::EpiBf16, FoldUnits, pg8::Gemm1>(lds + RING_OFF, gf, Sf, Ef, wave);
        }
    } else {
        PHASE_IDS();
        const bool split = p0_split;
        const bool defer_wdown = (G == 256);
        const int gwb = split ? (vcu - MKV_CUS) * NWAVES + wave : gw, NGWB = split ? (G - MKV_CUS) * NWAVES : NGW;
        LAS float* scr = (LAS float*)(lds + RING_OFF + wave * 16384);
        constexpr int I_IN = 64 * 640, I_A = 32 * 128, I_B = 0, I_C = 16 * 128, I_O = 64 * 128, I_UP = 64 * 688, I_DN = 172 * 128, I_PL = 0;
        constexpr int NITEMS = I_IN + I_A + I_B + I_C + I_O + I_UP + I_DN + I_PL;
        for (int it = gwb; it < NITEMS; it += NGWB) {
            int r = it;
            if (r < I_IN) { const int kb = r / 640, nb = r % 640;
                if (nb < 224) transpose_item(w_in, NIN, 64 * kb, 32 * nb, W_IN, 4096, 32 * nb, scr, lane, g_attn);
                else transpose_item_fp8(w_in, NIN, 64 * kb, 32 * nb, WG8, 4096, 32 * nb - 7168, scr, lane, 64.0f);
                continue; }
            r -= I_IN;
            if (r < I_A) { tr_plain<true>(w_a, 2048, 4096, W_A, scr, r, lane); continue; }
            r -= I_A;
            if (r < I_B) { continue; }
            r -= I_B;
            if (r < I_C) { tr_plain<true>(w_c, 1024, 4096, W_C, scr, r, lane); continue; }
            r -= I_C;
            if (r < I_O) { tr_plain<true>(w_o, 4096, 4096, W_O, scr, r, lane); continue; }
            r -= I_O;
            if (r < I_UP) {
                const int kb = r / 688, nb = r % 688, nd = 32 * nb, tile = nd >> 8, j = nd & 255;
                const int nsrc = (j < 128) ? tile * 128 + j : DFF + tile * 128 + (j - 128);
                transpose_item<true>(w_up, NUP, 64 * kb, nsrc, W_UP, 4096, nd, scr, lane, g_ffn); continue; }
            r -= I_UP;
            if (r < I_DN) { if (!defer_wdown) tr_plain(w_down, DFF, 4096, W_DOWN, scr, r, lane); continue; }
            r -= I_DN;
            (void)r;
        }
        { float* cws = (float*)(ws + WS_CWS);
          for (int i = gwb * 64 + lane; i < 4 * NUP; i += NGWB * 64) { const int k = i / NUP, c = i - k * NUP; const float sc = (c < DFF) ? -LOG2E : -(1.0f / LOG2E);
              cws[i] = ((k < 3) ? conv_w[(size_t)k * NUP + c] : conv_b[c]) * sc; } }
        for (int m = gwb; m < MTOK; m += NGWB) rms_row_4096(x + (size_t)m * DMODEL, g_attn, XB + (size_t)m * DMODEL, lane, H8 + (size_t)m * DMODEL, RS1 + m);
    }
    xcd_barrier(bar, wave);

    {
        pg8::Gemm8 g{H8, WG8, DMODEL}; pg8::StaticOrder S; S.init(MTOK, 13312, G, bx);
        pg8::EpiG8 E{GL, QM, g_qm, (LAS float*)(lds + XCH_OFF)};
        pg8::gemm_phase<pg8::EpiG8, pg8::StaticOrder, pg8::Gemm8>(lds + RING_OFF, g, S, E, wave);
    }
    {
        pg8::Gemm1 g{XB, W_IN, DMODEL, DMODEL, DMODEL, 0}; pg8::StaticOrder S; S.init(MTOK, 7168, G, bx);
        pg8::Unit u0; int pm_base = 0;
        if (S.next(0, u0)) pm_base = u0.pm & ~7;
        { PHASE_IDS();
          LAS float* tab = (LAS float*)(lds + RSTD_OFF);
#pragma unroll
          for (int k = 0; k < 4; ++k) tab[tid + 512 * k] = RS1[pm_base * 256 + tid + 512 * k];
          asm volatile("s_waitcnt lgkmcnt(0)\n\ts_barrier" ::: "memory"); }
        pg8::EpiProj E{QA, UPB, QM, nullptr, (const LAS float*)(lds + RSTD_OFF), pm_base, g_qa, g_ka, g_qm, (LAS float*)(lds + XCH_OFF), ROPE_INV2PI};
        pg8::gemm_phase<pg8::EpiProj, pg8::StaticOrder, pg8::Gemm1>(lds + RING_OFF, g, S, E, wave);
    }
    xcd_barrier(bar, wave);

    {
        PHASE_IDS();
        {
            pg8::StaticOrder S; S.init(MTOK, 1024, G, bx); pg8::Unit pu;
            for (int i = 0; S.next(i, pu); ++i) {
                const int gq = pu.pn, row0 = pu.pm * 256 + (tid >> 5) * 16, c = gq * 32 + (tid & 31);
                const bf16_t* src = UPB + (size_t)row0 * 1024 + c * 8; bf16_t* dst = YP + (size_t)row0 * 1024 + c * 8; const int t0 = row0 & (SEQ - 1);
                if (gq == 0) pool_prep_seg<2>(src, dst, t0); else if (gq == 1) pool_prep_seg<4>(src, dst, t0); else if (gq == 2) pool_prep_seg<8>(src, dst, t0); else pool_prep_seg<16>(src, dst, t0);
            }
        }
        float lam, negb_a;
        {
            const float a1 = lam_q1[lane] * lam_k1[lane] + lam_q1[lane + 64] * lam_k1[lane + 64];
            const float a2 = lam_q2[lane] * lam_k2[lane] + lam_q2[lane + 64] * lam_k2[lane + 64];
            lam = expf(wave_sum(a1)) - expf(wave_sum(a2)) + LAMBDA_INIT;
            const float gq = wave_max(fmaxf(fabsf(g_qa[lane]), fabsf(g_qa[lane + 64]))), gk = wave_max(fmaxf(fabsf(g_ka[lane]), fabsf(g_ka[lane + 64])));
            negb_a = -(11.313708498984761f * LOG2E * 1.02f) * gq * gk;
            lam = __uint_as_float(__builtin_amdgcn_readfirstlane(__float_as_uint(lam))); negb_a = __uint_as_float(__builtin_amdgcn_readfirstlane(__float_as_uint(negb_a)));
        }
        LAS float* wsf = (LAS float*)(lds + WSF_OFF) + wave * 64;
        if (G == 256) {
            const int bh = vcu >> 4, s = vcu & 15, b = bh >> 3, h = bh & 7;
            const int comp = wave >> 2, qg = (wave & 3) ^ (comp << 1);
#pragma unroll 1
            for (int ui = 0; ui < 4; ++ui) {
                const int qb = (ui == 0) ? s : (ui == 1) ? 31 - s : (ui == 2) ? 32 + s : 63 - s;
                const size_t rowbase = (size_t)b * SEQ; const int q0 = qb * 128 + qg * 32;
                f32x4 O[16][2]; float lq[2];
                att::attn_core16(O, lq, QA + (rowbase + q0) * 2048 + h * 256 + comp * 128, 2048, KA + rowbase * 2048 + h * 256, VA + rowbase * 2048 + h * 256, 2048,
                                 2 * qb + 2, 2 * qb + 1 + (qg >> 1), comp * 16, negb_a, lds + RING_OFF, wave);
                int ln = (int)__builtin_amdgcn_mbcnt_hi(~0u, __builtin_amdgcn_mbcnt_lo(~0u, 0u)); asm volatile("" : "+v"(ln));
                const int fr = ln & 15, fq = ln >> 4;
                LAS f32x4* stage = (LAS f32x4*)(lds + RING_OFF + qg * 32768) + ln;
                const float f0 = ((comp == 1) ? lam : 1.0f) * __builtin_amdgcn_rcpf(lq[0]), f1 = ((comp == 1) ? lam : 1.0f) * __builtin_amdgcn_rcpf(lq[1]);
#define DA_FIN(MINE) do { \
                    _Pragma("unroll") for (int db = 0; db < 16; ++db) stage[((1 - (MINE)) * 16 + db) * 64] = O[db][1 - (MINE)] * ((MINE) ? f0 : f1); \
                    asm volatile("s_waitcnt lgkmcnt(0)\n\ts_barrier" ::: "memory"); \
                    const float fm_ = (MINE) ? f1 : f0; float ss = 0.f; \
                    _Pragma("unroll") for (int db = 0; db < 16; ++db) { const f32x4 a_ = O[db][MINE] * fm_, b_ = stage[((MINE) * 16 + db) * 64]; const f32x4 v = (MINE) ? (b_ - a_) : (a_ - b_); O[db][MINE] = v; \
                        ss += (v[0] * v[0] + v[1] * v[1]) + (v[2] * v[2] + v[3] * v[3]); } \
                    ss += sx<16>(ss); ss = sum32x(ss); \
                    const float rn = (1.0f - LAMBDA_INIT) * __builtin_amdgcn_rsqf(ss * (1.f / 256.f) + EPS); \
                    const float* gp = g_subln + 4 * fq; asm volatile("" : "+v"(gp)); \
                    LAS unsigned char* rb_ = lds + RING_OFF + qg * 32768 + (MINE) * 16384;        \
                    _Pragma("unroll") for (int db = 0; db < 16; ++db) { const f32x4 g4 = *(const f32x4*)(gp + 16 * db); const f32x4 v = O[db][MINE] * rn * g4; \
                        u32x2 w; w.x = pk2(v[0], v[1]); w.y = pk2(v[2], v[3]); att::rowbuf_put(rb_, fr, fq, 0, db, w); } \
                    att::rowbuf_store<16>(rb_, ln, YA + (rowbase + q0 + (MINE) * 16) * 2048 + h * 256, 2048); } while (0)
                if (comp == 0) DA_FIN(0); else DA_FIN(1);
#undef DA_FIN
                asm volatile("s_waitcnt lgkmcnt(0)\n\ts_barrier" ::: "memory");
            }
        }
        if (G == 256) {
            PHASE_IDS();
            LAS float* wsf = (LAS float*)(lds + WSF_OFF) + wave * 64;
            const int bhm = vcu >> 5, qb = vcu & 31, b = bhm >> 2, hm = bhm & 3;
            const size_t rowbase = (size_t)b * SEQ; const int q0 = qb * 256 + wave * 32;
            float negb_m;
            { float m1 = 0.f, m2 = 0.f;
#pragma unroll
              for (int j = 0; j < 4; ++j) { m1 = fmaxf(m1, fabsf(g_qm[lane + 64 * j])); m2 = fmaxf(m2, fabsf(g_km[lane + 64 * j])); }
              negb_m = -(16.0f * LOG2E * 1.02f) * wave_max(m1) * wave_max(m2);
              negb_m = __uint_as_float(__builtin_amdgcn_readfirstlane(__float_as_uint(negb_m))); }
            att::mem_attn_core16(QM + (rowbase + q0) * 1024 + hm * 256, 1024, KVM + (size_t)b * MEMLEN * 2048 + hm * 256, KVM + (size_t)b * MEMLEN * 2048 + 1024 + hm * 256, 2048, negb_m, lds + RING_OFF, wave,
                                 YC + (rowbase + q0) * 1024 + hm * 256, 1024);
        }
    }
    xcd_barrier(bar, wave);

    {
        pg8::StaticOrder S; S.init(MTOK, DMODEL, G, bx);
        pg8::Gemm3 g{{YA, YP, YC}, {W_A, (const bf16_t*)(ws + WS_WBF), W_C}, {2048, 1024, 1024}};
        pg8::EpiMerge E{MERGED, GL};
        pg8::gemm_phase<pg8::EpiMerge, pg8::StaticOrder, pg8::Gemm3>(lds + RING_OFF, g, S, E, wave);
    }
    xcd_barrier(bar, wave);

    {
        pg8::Gemm1 g{MERGED, W_O, DMODEL, DMODEL, DMODEL, 0}; pg8::StaticOrder S; S.init(MTOK, DMODEL, G, bx);
        pg8::EpiX1 E{XB, X1B, SSQ};
        pg8::gemm_phase<pg8::EpiX1, pg8::StaticOrder, pg8::Gemm1>(lds + RING_OFF, g, S, E, wave);
    }
    xcd_barrier(bar, wave);

    {
        pg8::Gemm1 g{X1B, W_UP, DMODEL, DMODEL, DMODEL, 0}; pg8::StaticOrder S; S.init(MTOK, NUP, G, bx);
        pg8::Unit u0; int pm_base = 0;
        if (S.next(0, u0)) pm_base = u0.pm & ~7;
        {
            PHASE_IDS();
            LAS float* tab = (LAS float*)(lds + RSTD_OFF);
#pragma unroll 1
            for (int k = 0; k < 4; k += 2) {
                const int lr0 = tid + 512 * k, lr1 = lr0 + 512; const float* p0 = SSQ + (size_t)(pm_base * 256 + lr0) * 64; const float* p1 = p0 + (size_t)512 * 64;
                f32x4 v0[16], v1[16];
#pragma unroll
                for (int j = 0; j < 16; ++j) { v0[j] = *(const f32x4*)(p0 + 4 * j); v1[j] = *(const f32x4*)(p1 + 4 * j); }
                float q0 = 0.f, q1 = 0.f;
#pragma unroll
                for (int j = 0; j < 16; ++j) { q0 += (v0[j][0] + v0[j][1]) + (v0[j][2] + v0[j][3]); q1 += (v1[j][0] + v1[j][1]) + (v1[j][2] + v1[j][3]); }
                tab[lr0] = 1.0f / sqrtf(q0 * (1.f / 4096.f) + EPS); tab[lr1] = 1.0f / sqrtf(q1 * (1.f / 4096.f) + EPS); }
            asm volatile("s_waitcnt lgkmcnt(0)\n\ts_barrier" ::: "memory");
        }
        pg8::EpiUpConv E{ACT, (const float*)(ws + WS_CWS), (const float*)(ws + WS_CWS) + 3 * NUP, HALO, (LAS f32x4*)(lds + XCH_OFF), (const LAS float*)(lds + RSTD_OFF), pm_base};
        pg8::gemm_phase<pg8::EpiUpConv, pg8::StaticOrder, pg8::Gemm1>(lds + RING_OFF, g, S, E, wave);
        pg8::Unit ux;
        if (G == 256 && !S.next(21, ux)) {
            PHASE_IDS();
            LAS float* scr = (LAS float*)(lds + RING_OFF + wave * 16384);
            const int gwi = (bx - 128) * NWAVES + wave;
            if (bx >= 128) for (int it = gwi; it < 172 * 128; it += 128 * NWAVES) tr_plain(w_down, DFF, 4096, W_DOWN, scr, it, lane);
        }
    }
    xcd_barrier(bar, wave);
    {
        PHASE_IDS();
        const int gt = vcu * (NWAVES * 64) + tid, NGT = G * NWAVES * 64;
        for (int idx = gt; idx < 64 * (DFF / 4); idx += NGT) {
            const int pm = idx / (DFF / 4), ch = (idx - pm * (DFF / 4)) * 4;
            if ((pm & 31) == 0) continue;
            f32x4 yy[2][2];
#pragma unroll
            for (int bj = 0; bj < 2; ++bj) { const int col = bj * DFF + ch;
                const f32x4 um2 = *(const f32x4*)(HALO + (size_t)((pm - 1) * 4 + 2) * NUP + col), um1 = *(const f32x4*)(HALO + (size_t)((pm - 1) * 4 + 3) * NUP + col);
                const f32x4 u0v = *(const f32x4*)(HALO + (size_t)(pm * 4 + 0) * NUP + col), u1v = *(const f32x4*)(HALO + (size_t)(pm * 4 + 1) * NUP + col);
                const f32x4 w0 = *(const f32x4*)(conv_w + col), w1 = *(const f32x4*)(conv_w + NUP + col), w2 = *(const f32x4*)(conv_w + 2 * NUP + col), bb = *(const f32x4*)(conv_b + col);
                yy[bj][0] = w2 * u0v + w1 * um1 + w0 * um2 + bb; yy[bj][1] = w2 * u1v + w1 * u0v + w0 * um1 + bb; }
#pragma unroll
            for (int r = 0; r < 2; ++r) { f32x4 y;
#pragma unroll
                for (int e = 0; e < 4; ++e) { const float gv = yy[0][r][e]; y[e] = gv * sigmoidf_fast(gv) * yy[1][r][e]; }
                u32x2 w; w.x = pk2(y[0], y[1]); w.y = pk2(y[2], y[3]); *(u32x2*)(ACT + (size_t)(pm * 256 + r) * DFF + ch) = w; }
        }
    }
    xcd_barrier(bar, wave);

    {
        pg8::Gemm1 g{ACT, W_DOWN, DFF, DFF, DFF, 0}; pg8::StaticOrder S; S.init(MTOK, DMODEL, G, bx);
        pg8::EpiOut E{X1B, out};
        pg8::gemm_phase<pg8::EpiOut, pg8::StaticOrder, pg8::Gemm1>(lds + RING_OFF, g, S, E, wave);
    }
}

extern "C" void kernel_launch(void* const* d_in, const int* in_sizes, int n_in, void* d_out, int out_size, void* d_ws, size_t ws_size, hipStream_t stream) {
    static int grid = 0;
    if (grid == 0) {
        if (n_in != 26 || in_sizes[0] != MTOK * DMODEL || out_size != MTOK * DMODEL || ws_size < WS_END) {
            fprintf(stderr, "kernel_launch: unexpected shapes: n_in %d in0 %d out %d ws %zu (need %zu)\n", n_in, n_in > 0 ? in_sizes[0] : -1, out_size, ws_size, (size_t)WS_END); grid = -1; return; }
        int dev = 0, cus = 0, per_cu = 0;
        if (hipGetDevice(&dev) != hipSuccess || hipDeviceGetAttribute(&cus, hipDeviceAttributeMultiprocessorCount, dev) != hipSuccess) { grid = -1; return; }
        if (hipFuncSetAttribute((const void*)mk_fwd, hipFuncAttributeMaxDynamicSharedMemorySize, LDS_BYTES) != hipSuccess) { fprintf(stderr, "kernel_launch: hipFuncSetAttribute failed\n"); grid = -1; return; }
        if (hipOccupancyMaxActiveBlocksPerMultiprocessor(&per_cu, (const void*)mk_fwd, NWAVES * 64, LDS_BYTES) != hipSuccess || per_cu < 1)
            fprintf(stderr, "kernel_launch: note: occupancy query reports %d workgroups per CU\n", per_cu);
        (void)hipGetLastError();
        grid = cus;
        if (grid != 256) fprintf(stderr, "kernel_launch: %d CUs; the attention phase is dealt for 256\n", grid);
    }
    if (grid < 0) return;
    if (hipMemsetAsync((char*)d_ws + WS_CTL, 0, CTL_ZERO_BYTES, stream) != hipSuccess) return;
    Args a{};
    for (int i = 0; i < 26; ++i) a.in[i] = (const float*)d_in[i];
    a.out = (float*)d_out; a.ws = (unsigned char*)d_ws;
    hipLaunchKernelGGL(mk_fwd, dim3(grid), dim3(NWAVES * 64), LDS_BYTES, stream, a);
}
```
